# Optimizing an MI355X kernel written in HIP

```python
import math
import jax, jax.numpy as jnp
from jax import lax
import numpy as np

D_MODEL = 1024
BATCH = 16
SEQ = 2048
DEPTH = 2

GRID_W = 64
CTX_LEN = 256

DN_HEADS = 4
DN_DK = 128
DN_DV = 128
DN_CONV = 3
DN_QKV = DN_HEADS * (2 * DN_DK + DN_DV)
RET_HEADS = 4
RET_DK = 128
RET_DV = 128
CHUNK = 64
EVEN_SIZES = (DN_QKV, DN_HEADS * DN_DV, 2 * DN_HEADS, 2 * DN_HEADS,
              RET_HEADS * RET_DK, RET_HEADS * RET_DK, RET_HEADS * RET_DV, RET_HEADS * RET_DV)
EVEN_IN = sum(EVEN_SIZES)
EVEN_MIX = DN_HEADS * DN_DV + RET_HEADS * RET_DV
DIFF_HEADS = 8
DIFF_HD = 64
DIFF_DV = 2 * DIFF_HD
ODD_IN = DIFF_HEADS * (4 * DIFF_HD + DIFF_DV)
ODD_MIX = DIFF_HEADS * DIFF_DV
Q_BLOCK = 128
D_FF = 2816
FFN_CONV = 3

ROPE_BASE = 10000.0
LN_EPS = 1e-5
NORM_EPS = 1e-6
DEEP_ALPHA = (2 * DEPTH) ** 0.25
DEEP_BETA = (8 * DEPTH) ** -0.25
N_EVEN = (DEPTH + 1) // 2
N_ODD = DEPTH // 2

kernel_name = 'hybrid_deltanet_retention_diffattn_dit'


def layer_norm(x, g, b):
    xf = x.astype(jnp.float32)
    mu = jnp.mean(xf, -1, keepdims=True)
    var = jnp.mean(jnp.square(xf - mu), -1, keepdims=True)
    y = (xf - mu) * lax.rsqrt(var + LN_EPS) * g.astype(jnp.float32) + b.astype(jnp.float32)
    return y.astype(x.dtype)


def rms_norm(x):
    xf = x.astype(jnp.float32)
    return xf * lax.rsqrt(jnp.mean(jnp.square(xf), -1, keepdims=True) + NORM_EPS)


def group_norm(x):
    xf = x.astype(jnp.float32)
    mu = jnp.mean(xf, -1, keepdims=True)
    var = jnp.mean(jnp.square(xf - mu), -1, keepdims=True)
    return (xf - mu) * lax.rsqrt(var + NORM_EPS)


def l2_normalize(x):
    xf = x.astype(jnp.float32)
    return xf * lax.rsqrt(jnp.sum(jnp.square(xf), -1, keepdims=True) + NORM_EPS)


def modulate(x, shift, scale):
    return x * (1 + scale) + shift


def to_heads(x, h):
    b, l, _ = x.shape
    return x.reshape(b, l, h, -1).transpose(0, 2, 1, 3)


def merge_heads(x):
    b, h, l, d = x.shape
    return x.transpose(0, 2, 1, 3).reshape(b, l, h * d)


def conv1d_centred(x, w):
    k = w.shape[0]
    p = k // 2
    l = x.shape[1]
    xp = jnp.pad(x, ((0, 0), (p, p), (0, 0)))
    out = xp[:, 0:l] * w[0]
    for i in range(1, k):
        out = out + xp[:, i:i + l] * w[i]
    return out


def dwconv2d_centred(x, w):
    k = w.shape[0]
    p = k // 2
    r, c = x.shape[1], x.shape[2]
    xp = jnp.pad(x, ((0, 0), (p, p), (p, p), (0, 0)))
    out = jnp.zeros_like(x)
    for i in range(k):
        for j in range(k):
            out = out + xp[:, i:i + r, j:j + c] * w[i, j]
    return out


def rope_1d(pos, dim):
    inv = ROPE_BASE ** (-jnp.arange(dim // 2, dtype=jnp.float32) / (dim // 2))
    return pos.astype(jnp.float32)[:, None] * inv[None]


def rope_2d(row, col, dim):
    n = dim // 4
    inv = ROPE_BASE ** (-jnp.arange(n, dtype=jnp.float32) / n)
    return jnp.concatenate([row.astype(jnp.float32)[:, None] * inv[None],
                            col.astype(jnp.float32)[:, None] * inv[None]], -1)


def apply_rotary(x, cos, sin):
    x1, x2 = jnp.split(x, 2, -1)
    return jnp.concatenate([x1 * cos - x2 * sin, x1 * sin + x2 * cos], -1)


def flip_seq(t):
    return jnp.flip(t, axis=2)


def gated_delta_chunked(q, k, v, log_a, beta, s0):
    f32 = jnp.float32
    q, k, v, log_a, beta = (t.astype(f32) for t in (q, k, v, log_a, beta))
    b, h, l, dk = q.shape
    dv = v.shape[-1]
    n = l // CHUNK
    q = q.reshape(b, h, n, CHUNK, dk)
    k = k.reshape(b, h, n, CHUNK, dk)
    v = v.reshape(b, h, n, CHUNK, dv)
    beta = beta.reshape(b, h, n, CHUNK)
    g = jnp.cumsum(log_a.reshape(b, h, n, CHUNK), -1)
    tri = jnp.tril(jnp.ones((CHUNK, CHUNK), bool))
    strict = jnp.tril(jnp.ones((CHUNK, CHUNK), bool), -1)
    dec_incl = jnp.exp(jnp.where(tri, g[..., :, None] - g[..., None, :], -jnp.inf))
    dec_strict = jnp.where(strict, dec_incl, 0.0)
    kb = k * beta[..., None]
    a_mat = jnp.einsum('bhnid,bhnjd->bhnij', kb, k) * dec_strict
    m_mat = a_mat + jnp.eye(CHUNK, dtype=f32)
    rhs = jnp.concatenate([v * beta[..., None], kb * jnp.exp(g)[..., None]], -1)
    sol = lax.linalg.triangular_solve(m_mat, rhs, left_side=True, lower=True, unit_diagonal=True)
    u_c, w_c = sol[..., :dv], sol[..., dv:]
    qk = jnp.einsum('bhnid,bhnjd->bhnij', q, k) * dec_incl
    q_g = q * jnp.exp(g)[..., None]
    k_g = k * jnp.exp(g[..., -1:] - g)[..., None]
    c_dec = jnp.exp(g[..., -1])
    xs = tuple(jnp.moveaxis(t, 2, 0) for t in (u_c, w_c, qk, q_g, k_g, c_dec))

    def step(s, inp):
        u_n, w_n, qk_n, qg_n, kg_n, cd_n = inp
        v_new = u_n - jnp.einsum('bhck,bhkv->bhcv', w_n, s)
        o = jnp.einsum('bhck,bhkv->bhcv', qg_n, s) + jnp.einsum('bhij,bhjv->bhiv', qk_n, v_new)
        s = cd_n[..., None, None] * s + jnp.einsum('bhck,bhcv->bhkv', kg_n, v_new)
        return s, o

    s, o = lax.scan(step, s0.astype(f32), xs)
    return jnp.moveaxis(o, 0, 2).reshape(b, h, l, dv), s


def retention_chunked(q, k, v, log_gamma, s0):
    f32 = jnp.float32
    q, k, v = (t.astype(f32) for t in (q, k, v))
    b, h, l, dk = q.shape
    dv = v.shape[-1]
    n = l // CHUNK
    q = q.reshape(b, h, n, CHUNK, dk)
    k = k.reshape(b, h, n, CHUNK, dk)
    v = v.reshape(b, h, n, CHUNK, dv)
    lg = log_gamma.astype(f32)[:, None]
    idx = jnp.arange(CHUNK, dtype=f32)
    rel = idx[:, None] - idx[None, :]
    dec = jnp.exp(jnp.where(rel >= 0, lg[:, :, None] * rel, -jnp.inf))
    o_in = jnp.einsum('bhnij,bhnjv->bhniv',
                      jnp.einsum('bhnid,bhnjd->bhnij', q, k) * dec[None, :, None], v)
    q_d = q * jnp.exp(lg * (idx + 1))[None, :, None, :, None]
    k_d = k * jnp.exp(lg * (CHUNK - 1 - idx))[None, :, None, :, None]
    c_dec = jnp.exp(lg[:, 0] * CHUNK)[None, :, None, None]
    xs = tuple(jnp.moveaxis(t, 2, 0) for t in (o_in, q_d, k_d, v))

    def step(s, inp):
        o_n, q_n, k_n, v_n = inp
        o = o_n + jnp.einsum('bhck,bhkv->bhcv', q_n, s)
        s = c_dec * s + jnp.einsum('bhck,bhcv->bhkv', k_n, v_n)
        return s, o

    s, o = lax.scan(step, s0.astype(f32), xs)
    return jnp.moveaxis(o, 0, 2).reshape(b, h, l, dv), s


def bidir_delta(q, k, v, log_a, beta, s_init):
    o_f, s_f = gated_delta_chunked(q, k, v, log_a[0], beta[0], s_init[0])
    o_b, s_b = gated_delta_chunked(flip_seq(q), flip_seq(k), flip_seq(v),
                                   flip_seq(log_a[1]), flip_seq(beta[1]), s_init[1])
    return o_f + flip_seq(o_b), (s_f, s_b)


def bidir_retention(q, k, v, log_gamma, s_init):
    o_f, s_f = retention_chunked(q, k, v, log_gamma[0], s_init[0])
    o_b, s_b = retention_chunked(flip_seq(q), flip_seq(k), flip_seq(v), log_gamma[1], s_init[1])
    return o_f + flip_seq(o_b), (s_f, s_b)


def even_mixer(h, hc, w_in, conv_w, a_log, dt_bias, norm_w, ret_decay, w_out, rot, need_ctx):
    f32 = jnp.float32
    splits = np.cumsum(EVEN_SIZES)[:-1].tolist()

    def project(t, rot_t):
        bt, lt = t.shape[:2]
        qkv, z, a_raw, b_raw, rq, rk, rv, rg = jnp.split(t @ w_in, splits, -1)
        qkv = jax.nn.silu(conv1d_centred(qkv, conv_w))
        q, k, v = jnp.split(qkv, [DN_HEADS * DN_DK, 2 * DN_HEADS * DN_DK], -1)
        q = l2_normalize(to_heads(q, DN_HEADS)) * DN_DK ** -0.5
        k = l2_normalize(to_heads(k, DN_HEADS))
        v = to_heads(v, DN_HEADS)
        a_raw = a_raw.reshape(bt, lt, 2, DN_HEADS).transpose(2, 0, 3, 1).astype(f32)
        b_raw = b_raw.reshape(bt, lt, 2, DN_HEADS).transpose(2, 0, 3, 1).astype(f32)
        log_a = -jnp.exp(a_log.astype(f32))[:, None, :, None] * jax.nn.softplus(
            a_raw + dt_bias.astype(f32)[:, None, :, None])
        beta = jax.nn.sigmoid(b_raw)
        rq = rq.reshape(bt, lt, RET_HEADS, RET_DK)
        rk = rk.reshape(bt, lt, RET_HEADS, RET_DK)
        if rot_t is not None:
            rq = apply_rotary(rq, *rot_t)
            rk = apply_rotary(rk, *rot_t)
        rq = rq.transpose(0, 2, 1, 3)
        rk = rk.transpose(0, 2, 1, 3) * RET_DK ** -0.5
        rv = to_heads(rv, RET_HEADS)
        return (q, k, v, log_a, beta), (rq, rk, rv), z, rg

    def finish(o_dn, z, o_ret, g):
        dn = rms_norm(o_dn) * norm_w.astype(f32) * jax.nn.silu(to_heads(z, DN_HEADS).astype(f32))
        ret = merge_heads(group_norm(o_ret)) * jax.nn.silu(g.astype(f32))
        y = jnp.concatenate([merge_heads(dn), ret], -1)
        return y.astype(w_out.dtype) @ w_out

    log_gamma = -jnp.exp(ret_decay.astype(f32))
    dn_c, ret_c, z_c, g_c = project(hc, None)
    dn_l, ret_l, z_l, g_l = project(h, rot)
    bsz = h.shape[0]
    s0_dn = jnp.zeros((bsz, DN_HEADS, DN_DK, DN_DV), f32)
    s0_ret = jnp.zeros((bsz, RET_HEADS, RET_DK, RET_DV), f32)
    o_dn_c, st_dn = bidir_delta(*dn_c, (s0_dn, s0_dn))
    o_ret_c, st_ret = bidir_retention(*ret_c, log_gamma, (s0_ret, s0_ret))
    o_dn_l, _ = bidir_delta(*dn_l, st_dn)
    o_ret_l, _ = bidir_retention(*ret_l, log_gamma, st_ret)
    y = finish(o_dn_l, z_l, o_ret_l, g_l).astype(h.dtype)
    yc = finish(o_dn_c, z_c, o_ret_c, g_c).astype(h.dtype) if need_ctx else None
    return y, yc


def diff_mix(q, k, v, lam):
    s = jnp.einsum('cbhqd,cbhkd->cbhqk', q, k).astype(jnp.float32) * DIFF_HD ** -0.5
    p = jax.nn.softmax(s, -1)
    a = p[0] - lam * p[1]
    return jnp.einsum('bhqk,bhkd->bhqd', a.astype(v.dtype), v)


def odd_mixer(h, hc, w_qkv, lam_p, subln_w, w_out, rot, lambda_init, need_ctx):
    f32 = jnp.float32

    def project(t, rot_t):
        bt, lt = t.shape[:2]
        q, k, v = jnp.split(t @ w_qkv, [DIFF_HEADS * 2 * DIFF_HD, 2 * DIFF_HEADS * 2 * DIFF_HD], -1)
        q = q.reshape(bt, lt, DIFF_HEADS, 2, DIFF_HD)
        k = k.reshape(bt, lt, DIFF_HEADS, 2, DIFF_HD)
        if rot_t is not None:
            q = apply_rotary(q, *rot_t)
            k = apply_rotary(k, *rot_t)
        return q.transpose(3, 0, 2, 1, 4), k.transpose(3, 0, 2, 1, 4), to_heads(v, DIFF_HEADS)

    lp = lam_p.astype(f32)
    lam = jnp.exp(jnp.sum(lp[0] * lp[1])) - jnp.exp(jnp.sum(lp[2] * lp[3])) + lambda_init
    qc, kc, vc = project(hc, None)
    ql, kl, vl = project(h, rot)
    k_all = jnp.concatenate([kl, kc], axis=3)
    v_all = jnp.concatenate([vl, vc], axis=2)
    bsz, nh, l = ql.shape[1], ql.shape[2], ql.shape[3]
    nb = l // Q_BLOCK
    qb = ql.reshape(2, bsz, nh, nb, Q_BLOCK, DIFF_HD).transpose(3, 0, 1, 2, 4, 5)
    ob = lax.map(lambda qq: diff_mix(qq, k_all, v_all, lam), qb)
    o_l = ob.transpose(1, 2, 0, 3, 4).reshape(bsz, nh, l, DIFF_DV)

    def finish(o):
        o = rms_norm(o) * subln_w.astype(f32) * (1.0 - lambda_init)
        return (merge_heads(o).astype(w_out.dtype) @ w_out).astype(h.dtype)

    y = finish(o_l)
    yc = finish(diff_mix(qc, kc, vc, lam)) if need_ctx else None
    return y, yc


def conv_ffn(h, rows, w_gate, w_up, w_conv, w_down):
    bt, lt, _ = h.shape
    a = h @ w_gate
    a = dwconv2d_centred(a.reshape(bt, rows, lt // rows, D_FF), w_conv).reshape(bt, lt, D_FF)
    return (jax.nn.silu(a) * (h @ w_up)) @ w_down


def setup_inputs(seed: int = 0) -> dict:
    key = jax.random.key(seed)
    ks = jax.random.split(key, 24)
    f32 = jnp.float32

    def nrm(k, shape, s):
        return jax.random.normal(k, shape, f32) * s

    x = nrm(ks[0], (BATCH, SEQ, D_MODEL), 1.0)
    c = nrm(ks[1], (BATCH, D_MODEL), 1.0)
    ctx = nrm(ks[2], (BATCH, CTX_LEN, D_MODEL), 1.0)
    c_ctx = nrm(ks[3], (D_MODEL,), 1.0)
    mod_w = nrm(ks[4], (DEPTH, D_MODEL, 6 * D_MODEL), 0.5 * D_MODEL ** -0.5)
    mod_b = nrm(ks[5], (DEPTH, 6 * D_MODEL), 0.02)
    ln_g = 1.0 + nrm(ks[6], (DEPTH, 2, D_MODEL), 0.02)
    ln_b = nrm(ks[7], (DEPTH, 2, D_MODEL), 0.02)
    e_w_in = nrm(ks[8], (N_EVEN, D_MODEL, EVEN_IN), D_MODEL ** -0.5)
    e_conv = nrm(ks[9], (N_EVEN, DN_CONV, DN_QKV), DN_CONV ** -0.5)
    e_a_log = jnp.log(jax.random.uniform(ks[10], (N_EVEN, 2, DN_HEADS), f32, 1.0, 16.0))
    dt = jnp.exp(jax.random.uniform(ks[11], (N_EVEN, 2, DN_HEADS), f32, math.log(1e-3), math.log(1e-1)))
    e_dt_bias = dt + jnp.log(-jnp.expm1(-dt))
    e_norm_w = 1.0 + nrm(ks[12], (N_EVEN, DN_DV), 0.02)
    base = jnp.log(-jnp.log1p(-jnp.power(2.0, -5.0 - jnp.arange(RET_HEADS, dtype=f32))))
    e_ret_decay = base + nrm(ks[13], (N_EVEN, 2, RET_HEADS), 0.05)
    e_w_out = nrm(ks[14], (N_EVEN, EVEN_MIX, D_MODEL), DEEP_BETA * EVEN_MIX ** -0.5)
    o_w_qkv = nrm(ks[15], (N_ODD, D_MODEL, ODD_IN), D_MODEL ** -0.5)
    o_lambda = nrm(ks[16], (N_ODD, 4, DIFF_HD), 0.1)
    o_subln_w = 1.0 + nrm(ks[17], (N_ODD, DIFF_DV), 0.02)
    o_w_out = nrm(ks[18], (N_ODD, ODD_MIX, D_MODEL), DEEP_BETA * ODD_MIX ** -0.5)
    f_w_gate = nrm(ks[19], (DEPTH, D_MODEL, D_FF), D_MODEL ** -0.5)
    f_w_up = nrm(ks[20], (DEPTH, D_MODEL, D_FF), D_MODEL ** -0.5)
    f_conv = nrm(ks[21], (DEPTH, FFN_CONV, FFN_CONV, D_FF), 1.0 / FFN_CONV)
    f_w_down = nrm(ks[22], (DEPTH, D_FF, D_MODEL), DEEP_BETA * D_FF ** -0.5)
    return {'x': x, 'c': c, 'ctx': ctx, 'c_ctx': c_ctx, 'mod_w': mod_w, 'mod_b': mod_b,
            'ln_g': ln_g, 'ln_b': ln_b, 'e_w_in': e_w_in, 'e_conv': e_conv, 'e_a_log': e_a_log,
            'e_dt_bias': e_dt_bias, 'e_norm_w': e_norm_w, 'e_ret_decay': e_ret_decay,
            'e_w_out': e_w_out, 'o_w_qkv': o_w_qkv, 'o_lambda': o_lambda, 'o_subln_w': o_subln_w,
            'o_w_out': o_w_out, 'f_w_gate': f_w_gate, 'f_w_up': f_w_up, 'f_conv': f_conv,
            'f_w_down': f_w_down}


def reference(x, c, ctx, c_ctx, mod_w, mod_b, ln_g, ln_b, e_w_in, e_conv, e_a_log, e_dt_bias,
              e_norm_w, e_ret_decay, e_w_out, o_w_qkv, o_lambda, o_subln_w, o_w_out,
              f_w_gate, f_w_up, f_conv, f_w_down):
    l = x.shape[1]
    rows = l // GRID_W
    pos = jnp.arange(l)
    ret_ang = rope_1d(pos, RET_DK)
    diff_ang = rope_2d(pos // GRID_W, pos % GRID_W, DIFF_HD)
    ret_rot = (jnp.cos(ret_ang)[None, :, None, :].astype(x.dtype),
               jnp.sin(ret_ang)[None, :, None, :].astype(x.dtype))
    diff_rot = (jnp.cos(diff_ang)[None, :, None, None, :].astype(x.dtype),
                jnp.sin(diff_ang)[None, :, None, None, :].astype(x.dtype))
    c_act = jax.nn.silu(c)
    cc_act = jax.nn.silu(c_ctx)
    for li in range(DEPTH):
        last = li == DEPTH - 1
        mod = (c_act @ mod_w[li] + mod_b[li])[:, None, :]
        modc = cc_act @ mod_w[li] + mod_b[li]
        sh_a, sc_a, g_a, sh_f, sc_f, g_f = jnp.split(mod, 6, -1)
        csh_a, csc_a, cg_a, csh_f, csc_f, cg_f = jnp.split(modc, 6, -1)
        h = modulate(x, sh_a, sc_a)
        hc = modulate(ctx, csh_a, csc_a)
        i = li // 2
        if li % 2 == 0:
            y, yc = even_mixer(h, hc, e_w_in[i], e_conv[i], e_a_log[i], e_dt_bias[i], e_norm_w[i],
                               e_ret_decay[i], e_w_out[i], ret_rot, not last)
        else:
            lambda_init = 0.8 - 0.6 * math.exp(-0.3 * li)
            y, yc = odd_mixer(h, hc, o_w_qkv[i], o_lambda[i], o_subln_w[i], o_w_out[i], diff_rot,
                              lambda_init, not last)
        x = layer_norm(DEEP_ALPHA * x + g_a * y, ln_g[li, 0], ln_b[li, 0])
        hf = modulate(x, sh_f, sc_f)
        x = layer_norm(DEEP_ALPHA * x + g_f * conv_ffn(hf, rows, f_w_gate[li], f_w_up[li], f_conv[li], f_w_down[li]),
                       ln_g[li, 1], ln_b[li, 1])
        if not last:
            ctx = layer_norm(DEEP_ALPHA * ctx + cg_a * yc, ln_g[li, 0], ln_b[li, 0])
            hcf = modulate(ctx, csh_f, csc_f)
            ctx = layer_norm(DEEP_ALPHA * ctx + cg_f * conv_ffn(hcf, 1, f_w_gate[li], f_w_up[li], f_conv[li], f_w_down[li]),
                             ln_g[li, 1], ln_b[li, 1])
    return x
```

```cpp
#include <hip/hip_runtime.h>
#include <hip/hip_cooperative_groups.h>
#include <cstdio>
#include <cstdint>
namespace cg = cooperative_groups;

#define LAS __attribute__((address_space(3)))
typedef unsigned short bf16_t;
typedef short bf16x8 __attribute__((ext_vector_type(8)));
typedef short s16x4 __attribute__((ext_vector_type(4)));
typedef float f32x4 __attribute__((ext_vector_type(4)));
typedef float f32x2 __attribute__((ext_vector_type(2)));
typedef float f32x16 __attribute__((ext_vector_type(16)));
typedef unsigned u32x4 __attribute__((ext_vector_type(4)));
typedef unsigned u32x2 __attribute__((ext_vector_type(2)));
typedef __bf16 bf16x2_t __attribute__((ext_vector_type(2)));

constexpr int D = 1024, NB = 16, SEQL = 2048, CTXL = 256;
constexpr int ML = NB * SEQL, MC = NB * CTXL, MT = ML + MC;
constexpr int DFF = 2816;
constexpr int NWAVES = 8, NTHREADS = 512;
constexpr float LN_EPS = 1e-5f, NORM_EPS = 1e-6f;
constexpr float DEEP_ALPHA = 1.41421356237309515f;
constexpr float LAMBDA_INIT1 = 0.8f - 0.6f * 0.74081822068171788f;
constexpr float ATT_C2 = 0.125f * 1.4426950408889634f;

constexpr size_t MiB = 1u << 20;
constexpr size_t WS_CTL = 0;
constexpr size_t WS_MOD = 128 * 1024;
constexpr size_t WS_RETCS = 1 * MiB;
constexpr size_t WS_DIFFCS = 2 * MiB;
constexpr size_t WS_XRC = 3 * MiB;
constexpr size_t WS_WGU = 19 * MiB;
constexpr size_t WS_WD = 30 * MiB;
constexpr size_t WS_H = 35 * MiB + 512 * 1024;
constexpr size_t WS_BIG = 107 * MiB + 512 * 1024;
constexpr size_t WS_WIN = WS_BIG;
constexpr size_t WS_WOUT0 = WS_BIG + 8 * MiB + 512 * 1024;
constexpr size_t WS_QKVR = 118 * MiB;
constexpr size_t WS_Z = 226 * MiB;
constexpr size_t WS_RQ = 262 * MiB, WS_RK = 298 * MiB, WS_RV = 334 * MiB, WS_RG = 370 * MiB;
constexpr size_t WS_AB = 406 * MiB;
constexpr size_t WS_O3 = 409 * MiB;
constexpr size_t WS_G = WS_BIG;
constexpr size_t WS_U = WS_BIG + 198 * MiB;
constexpr size_t WS_Q1 = WS_BIG, WS_K1 = WS_BIG + 72 * MiB, WS_VT = WS_BIG + 144 * MiB, WS_Y1 = WS_BIG + 216 * MiB;
constexpr size_t WS_WQK1 = 400 * MiB, WS_WV1 = 404 * MiB, WS_WO1 = 406 * MiB;
constexpr size_t WS_END = WS_U + 198 * MiB;
static_assert(WS_END <= 512 * MiB, "ws map");
constexpr int LDS_BYTES = 147456;

__device__ __forceinline__ unsigned cvtpk(float lo, float hi) { f32x2 v = {lo, hi}; bf16x2_t b = __builtin_convertvector(v, bf16x2_t); return __builtin_bit_cast(unsigned, b); }
__device__ __forceinline__ bf16_t f2bf(float f) { return (bf16_t)(cvtpk(f, 0.f) & 0xffffu); }
__device__ __forceinline__ float bf2f(unsigned short b) { return __uint_as_float(((unsigned)b) << 16); }
__device__ __forceinline__ float bflo(unsigned w) { return __uint_as_float(w << 16); }
__device__ __forceinline__ float bfhi(unsigned w) { return __uint_as_float(w & 0xffff0000u); }
__device__ __forceinline__ float silu_f(float x) { return x / (1.f + __expf(-x)); }
__device__ __forceinline__ float sigmoid_f(float x) { return 1.f / (1.f + __expf(-x)); }
__device__ __forceinline__ float wave_sum(float v) {
#pragma unroll
    for (int o = 1; o < 64; o <<= 1) v += __shfl_xor(v, o);
    return v;
}
__device__ __forceinline__ int crow(int r, int hi) { return (r & 3) + 8 * (r >> 2) + 4 * hi; }

namespace pg8 {
constexpr int BM = 256, BK = 64, HALF = 128, HTB = HALF * BK * 2, STAGE_BYTES = 8 * HTB, NXCD = 8, WGM = 8;
__host__ __device__ __forceinline__ int lds_byte(int r, int c) { const int st = (r >> 4) * 2 + (c >> 5), rr = r & 15, cc = c & 31, ob = rr * 64 + cc * 2; return st * 1024 + (ob ^ (((ob >> 9) & 1) << 5)); }
__host__ __device__ __forceinline__ void stage_rc(int b, int& R, int& C) { const int st = b / 1024, sb = b % 1024, swz = sb ^ (((sb >> 9) & 1) << 5); R = (st >> 1) * 16 + swz / 64; C = (st & 1) * 32 + (swz % 64) / 2; }
__host__ __device__ __forceinline__ int perm32(int rho) { const int n = rho >> 4, i = rho & 15; return 8 * (i >> 2) + 4 * n + (i & 3); }

struct Unit { int pm, pn, g; };
struct GemmDesc { const bf16_t* A; const bf16_t* Bt; int nM, nN; };

struct Order {
    const bf16_t *A0, *B0, *A1, *B1; int nM0, nN0, nM1, nN1; int K, G, c; int nwg0, nwg1;
    __device__ void init(int K_, int G_, int c_, GemmDesc g0) { K = K_; G = G_; c = c_; A0 = g0.A; B0 = g0.Bt; nM0 = g0.nM; nN0 = g0.nN; A1 = g0.A; B1 = g0.Bt; nM1 = 1; nN1 = 1; nwg0 = g0.nM * g0.nN; nwg1 = 0; }
    __device__ void init2(int K_, int G_, int c_, GemmDesc g0, GemmDesc g1) { K = K_; G = G_; c = c_; A0 = g0.A; B0 = g0.Bt; nM0 = g0.nM; nN0 = g0.nN; A1 = g1.A; B1 = g1.Bt; nM1 = g1.nM; nN1 = g1.nN; nwg0 = nM0 * nN0; nwg1 = nM1 * nN1; }
    __device__ bool next(int i, Unit& u) const {
        long L = (long)i * G + c; if (L >= nwg0 + nwg1) return false;
        int gi = 0, nwg = nwg0; if (L >= nwg0) { gi = 1; L -= nwg0; nwg = nwg1; }
        const int nM = gi ? nM1 : nM0, nN = gi ? nN1 : nN0;
        int wgid = (int)L; { const int q = nwg / NXCD, r = nwg % NXCD, xcd = wgid % NXCD, off = wgid / NXCD; wgid = (xcd < r ? xcd * (q + 1) : r * (q + 1) + (xcd - r) * q) + off; }
        const int nig = WGM * nN, gid = wgid / nig, fm = gid * WGM, gsz = (nM - fm) < WGM ? (nM - fm) : WGM;
        u.pm = fm + ((wgid % nig) % gsz); u.pn = (wgid % nig) / gsz; u.g = gi; return true;
    }
    __device__ __forceinline__ const char* abase(const Unit& u) const { return (const char*)(u.g ? A1 : A0) + (size_t)u.pm * (size_t)(BM * 2) * K; }
    __device__ __forceinline__ const char* bbase(const Unit& u) const { return (const char*)(u.g ? B1 : B0) + (size_t)u.pn * (size_t)(BM * 2) * K; }
};

template <class Epi, bool SP2 = true>
__device__ __forceinline__ void gemm_phase(LAS unsigned char* lds, const Order& S, const Epi& E) {
    const int tid = threadIdx.x, wid = __builtin_amdgcn_readfirstlane(tid >> 6), lane = tid & 63, wr = wid >> 2, wc = wid & 3, fr = lane & 15, fq = lane >> 4;
    const int K = S.K, nt = K / BK;
    unsigned voffA[2], voffB[2];
#pragma unroll
    for (int i = 0; i < 2; ++i) { int R, C; stage_rc(tid * 16 + i * 8192, R, C); const int Rb = Epi::PERM ? ((R & ~31) + perm32(R & 31)) : R;
        voffA[i] = (unsigned)(R * K + C) * 2u; voffB[i] = (unsigned)(Rb * K + C) * 2u; }
    const size_t kstep = (size_t)(BK * 2);
    const size_t hstep = (size_t)HALF * K * 2;
    const unsigned ldsw = (unsigned)wid * 1024u;
    const int aoff = lds_byte(wr * 64 + fr, fq * 8), boff = lds_byte(wc * 32 + fr, fq * 8);
#define PG8_SA(b, h) (((b) * 2 + (h)) * HTB)
#define PG8_SB(b, h) ((4 + (b) * 2 + (h)) * HTB)
#define PG8_STAGE(bufoff, gbase, voff) do { _Pragma("unroll") for (int _i = 0; _i < 2; ++_i) \
        __builtin_amdgcn_global_load_lds((const unsigned*)((const char*)(gbase) + (voff)[_i]), (LAS unsigned*)(lds + (bufoff) + ldsw + _i * 8192), 16, 0, 0); } while (0)
#define PG8_LDA(dst, b, h) do { _Pragma("unroll") for (int m = 0; m < 4; ++m) _Pragma("unroll") for (int k = 0; k < 2; ++k) dst[m][k] = *(const LAS bf16x8*)(lds + PG8_SA(b, h) + aoff + m * 2048 + k * 1024); } while (0)
#define PG8_LDB(dst, b, h) do { _Pragma("unroll") for (int n = 0; n < 2; ++n) _Pragma("unroll") for (int k = 0; k < 2; ++k) dst[n][k] = *(const LAS bf16x8*)(lds + PG8_SB(b, h) + boff + n * 2048 + k * 1024); } while (0)
#define PG8_MMA(ai, bj, At, Bt) do { __builtin_amdgcn_s_setprio(1); _Pragma("unroll") for (int m = 0; m < 4; ++m) _Pragma("unroll") for (int n = 0; n < 2; ++n) _Pragma("unroll") for (int k = 0; k < 2; ++k) \
        acc[ai][bj][m][n] = __builtin_amdgcn_mfma_f32_16x16x32_bf16(Bt[n][k], At[m][k], acc[ai][bj][m][n], 0, 0, 0); __builtin_amdgcn_s_setprio(0); } while (0)
#define PG8_WAIT_V(n) asm volatile("s_waitcnt vmcnt(" #n ")" ::: "memory")
#define PG8_WAIT_L(n) asm volatile("s_waitcnt lgkmcnt(" #n ")" ::: "memory")
#define PG8_BAR __builtin_amdgcn_s_barrier()
#define PG8_SCHED __builtin_amdgcn_sched_barrier(0)
    Unit cur, nxt; int ui = 0;
    if (!S.next(0, cur)) return;
    f32x4 acc[2][2][4][2];
#pragma unroll
    for (int a = 0; a < 2; ++a)
#pragma unroll
        for (int b = 0; b < 2; ++b)
#pragma unroll
            for (int m = 0; m < 4; ++m)
#pragma unroll
                for (int n = 0; n < 2; ++n) acc[a][b][m][n] = (f32x4){0.f, 0.f, 0.f, 0.f};
    bf16x8 At[4][2], B0[2][2], B1[2][2];
    const char* cA = S.abase(cur); const char* cB = S.bbase(cur);
    if constexpr (SP2) {
        PG8_STAGE(PG8_SB(0, 0), cB, voffB); PG8_STAGE(PG8_SB(0, 1), cB + hstep, voffB); PG8_STAGE(PG8_SA(0, 0), cA, voffA); PG8_STAGE(PG8_SA(0, 1), cA + hstep, voffA);
        if (wr == 1) PG8_BAR;
        PG8_WAIT_V(2); PG8_BAR;
        PG8_STAGE(PG8_SB(1, 0), cB + kstep, voffB); PG8_STAGE(PG8_SA(1, 0), cA + kstep, voffA); PG8_STAGE(PG8_SB(1, 1), cB + hstep + kstep, voffB);
        PG8_WAIT_V(6); PG8_BAR;
    } else {
        PG8_STAGE(PG8_SB(0, 0), cB, voffB); PG8_STAGE(PG8_SA(0, 0), cA, voffA); PG8_STAGE(PG8_SB(0, 1), cB + hstep, voffB); PG8_STAGE(PG8_SA(0, 1), cA + hstep, voffA);
        if (wr == 1) PG8_BAR;
        PG8_WAIT_V(4); PG8_BAR;
        PG8_STAGE(PG8_SB(1, 0), cB + kstep, voffB); PG8_STAGE(PG8_SA(1, 0), cA + kstep, voffA); PG8_STAGE(PG8_SB(1, 1), cB + hstep + kstep, voffB);
        PG8_WAIT_V(6); PG8_BAR;
    }
    for (;;) {
        const bool has_next = S.next(ui + 1, nxt);
        const char* nA = has_next ? S.abase(nxt) : cA; const char* nB = has_next ? S.bbase(nxt) : cB;
        for (int t = 0; t < nt; t += 2) {
            const bool last = (t == nt - 2);
            const char* a1 = cA + (size_t)(t + 1) * kstep;
            const char* a2 = last ? nA : cA + (size_t)(t + 2) * kstep; const char* b2 = last ? nB : cB + (size_t)(t + 2) * kstep;
            const char* a3 = a2 + kstep; const char* b3 = b2 + kstep;
            if constexpr (SP2) {
            PG8_LDB(B0, 0, 0); PG8_LDB(B1, 0, 1); PG8_SCHED; PG8_LDA(At, 0, 0); PG8_STAGE(PG8_SA(1, 1), a1 + hstep, voffA);
            PG8_WAIT_V(8); PG8_WAIT_L(0); PG8_BAR; PG8_MMA(0, 0, At, B0); PG8_MMA(0, 1, At, B1); PG8_BAR; PG8_SCHED;
            PG8_LDA(At, 0, 1); PG8_STAGE(PG8_SB(0, 0), b2, voffB); PG8_STAGE(PG8_SB(0, 1), b2 + hstep, voffB); PG8_STAGE(PG8_SA(0, 0), a2, voffA);
            PG8_WAIT_V(8); PG8_WAIT_L(0); PG8_BAR; PG8_MMA(1, 0, At, B0); PG8_MMA(1, 1, At, B1); PG8_BAR; PG8_SCHED;
            PG8_LDB(B0, 1, 0); PG8_LDB(B1, 1, 1); PG8_SCHED; PG8_LDA(At, 1, 0); PG8_STAGE(PG8_SA(0, 1), a2 + hstep, voffA);
            PG8_WAIT_V(8); PG8_WAIT_L(0); PG8_BAR; PG8_MMA(0, 0, At, B0); PG8_MMA(0, 1, At, B1); PG8_BAR; PG8_SCHED;
            PG8_LDA(At, 1, 1); PG8_STAGE(PG8_SB(1, 0), b3, voffB); PG8_STAGE(PG8_SB(1, 1), b3 + hstep, voffB); PG8_STAGE(PG8_SA(1, 0), a3, voffA);
            PG8_WAIT_V(8); PG8_WAIT_L(0); PG8_BAR; PG8_MMA(1, 0, At, B0); PG8_MMA(1, 1, At, B1); PG8_BAR; PG8_SCHED;
            } else {
            PG8_LDB(B0, 0, 0); PG8_SCHED; PG8_LDA(At, 0, 0); PG8_STAGE(PG8_SA(1, 1), a1 + hstep, voffA);
            PG8_WAIT_L(8); PG8_BAR; PG8_WAIT_L(0); PG8_MMA(0, 0, At, B0); PG8_BAR; PG8_SCHED;
            PG8_LDB(B1, 0, 1); PG8_STAGE(PG8_SB(0, 0), b2, voffB);
            PG8_BAR; PG8_WAIT_L(0); PG8_MMA(0, 1, At, B1); PG8_BAR;
            PG8_LDA(At, 0, 1); PG8_STAGE(PG8_SA(0, 0), a2, voffA);
            PG8_BAR; PG8_WAIT_L(0); PG8_MMA(1, 0, At, B0); PG8_BAR; PG8_SCHED;
            PG8_STAGE(PG8_SB(0, 1), b2 + hstep, voffB);
            PG8_WAIT_V(6); PG8_BAR; PG8_MMA(1, 1, At, B1); PG8_BAR;
            PG8_LDB(B0, 1, 0); PG8_SCHED; PG8_LDA(At, 1, 0); PG8_STAGE(PG8_SA(0, 1), a2 + hstep, voffA);
            PG8_WAIT_L(8); PG8_BAR; PG8_WAIT_L(0); PG8_MMA(0, 0, At, B0); PG8_BAR; PG8_SCHED;
            PG8_LDB(B1, 1, 1); PG8_STAGE(PG8_SB(1, 0), b3, voffB);
            PG8_BAR; PG8_WAIT_L(0); PG8_MMA(0, 1, At, B1); PG8_BAR;
            PG8_LDA(At, 1, 1); PG8_STAGE(PG8_SA(1, 0), a3, voffA);
            PG8_BAR; PG8_WAIT_L(0); PG8_MMA(1, 0, At, B0); PG8_BAR; PG8_SCHED;
            PG8_STAGE(PG8_SB(1, 1), b3 + hstep, voffB);
            PG8_WAIT_V(6); PG8_BAR; PG8_MMA(1, 1, At, B1); PG8_BAR;
            }
        }
        if (wr == 0) PG8_BAR;
        E(acc, cur, wr, wc, fr, fq);
        if (!has_next) break;
#pragma unroll
        for (int a = 0; a < 2; ++a)
#pragma unroll
            for (int b = 0; b < 2; ++b)
#pragma unroll
                for (int m = 0; m < 4; ++m)
#pragma unroll
                    for (int n = 0; n < 2; ++n) acc[a][b][m][n] = (f32x4){0.f, 0.f, 0.f, 0.f};
        cur = nxt; cA = nA; cB = nB; ++ui;
        if (wr == 1) PG8_BAR;
    }
    PG8_WAIT_V(0);
    PG8_BAR;
#undef PG8_SA
#undef PG8_SB
#undef PG8_STAGE
#undef PG8_LDA
#undef PG8_LDB
#undef PG8_MMA
#undef PG8_WAIT_V
#undef PG8_WAIT_L
#undef PG8_BAR
#undef PG8_SCHED
}
}
namespace epi {
using pg8::Unit; using pg8::BM; using pg8::HALF;
__device__ __forceinline__ void rot8(f32x4& v0, f32x4& v1, const f32x4 a, const f32x4 b) {
    float x, y;
    x = v0[0]; y = v0[1]; v0[0] = x * a[0] - y * a[1]; v0[1] = x * a[1] + y * a[0];
    x = v0[2]; y = v0[3]; v0[2] = x * a[2] - y * a[3]; v0[3] = x * a[3] + y * a[2];
    x = v1[0]; y = v1[1]; v1[0] = x * b[0] - y * b[1]; v1[1] = x * b[1] + y * b[0];
    x = v1[2]; y = v1[3]; v1[2] = x * b[2] - y * b[3]; v1[3] = x * b[3] + y * b[2];
}
__device__ __forceinline__ u32x4 pack8(const f32x4 v0, const f32x4 v1) { u32x4 w; w.x = cvtpk(v0[0], v0[1]); w.y = cvtpk(v0[2], v0[3]); w.z = cvtpk(v1[0], v1[1]); w.w = cvtpk(v1[2], v1[3]); return w; }

struct EpiIn {
    static constexpr bool PERM = true;
    bf16_t *QKVR, *Z, *RQ, *RK, *RV, *RG; const float* retcs;
    __device__ __forceinline__ void operator()(const f32x4 (&acc)[2][2][4][2], const Unit& u, int wr, int wc, int fr, int fq) const {
        bf16_t* base; int ldc, colt; bool rot = false; float sc = 1.f;
        if (u.pn < 6) { base = QKVR; ldc = 1536; colt = u.pn * 256; }
        else { const int t = (u.pn - 6) >> 1; colt = ((u.pn - 6) & 1) * 256; ldc = 512; base = t == 0 ? Z : t == 1 ? RQ : t == 2 ? RK : t == 3 ? RV : RG;
               rot = (t == 1 || t == 2) && (u.pm < ML / 256); if (t == 2) sc = 0.088388347648318447f; }
        const int row0 = u.pm * BM + wr * 64 + fr, col0 = colt + wc * 32 + 8 * fq;
#pragma unroll
        for (int ai = 0; ai < 2; ++ai)
#pragma unroll
            for (int m = 0; m < 4; ++m) { const int row = row0 + ai * HALF + m * 16; const int pos = row & (SEQL - 1);
#pragma unroll
                for (int bj = 0; bj < 2; ++bj) { f32x4 v0 = acc[ai][bj][m][0], v1 = acc[ai][bj][m][1]; const int c = col0 + bj * HALF;
                    if (rot) { const f32x4* cs = (const f32x4*)(retcs + ((size_t)pos * 64 + ((c & 127) >> 1)) * 2); rot8(v0, v1, cs[0], cs[1]); }
                    v0 = v0 * sc; v1 = v1 * sc;
                    *(u32x4*)(base + (size_t)row * ldc + c) = pack8(v0, v1); } }
    }
};
struct EpiQKV1 {
    static constexpr bool PERM = true;
    bf16_t *Q1, *K1, *VT; const float* diffcs;
    __device__ __forceinline__ void operator()(const f32x4 (&acc)[2][2][4][2], const Unit& u, int wr, int wc, int fr, int fq) const {
        if (u.g == 1) {
            const int row0 = u.pm * BM + wr * 64 + fr, col0 = u.pn * BM + wc * 32 + 8 * fq;
#pragma unroll
            for (int ai = 0; ai < 2; ++ai)
#pragma unroll
                for (int m = 0; m < 4; ++m) { const int row = row0 + ai * HALF + m * 16;
#pragma unroll
                    for (int bj = 0; bj < 2; ++bj) *(u32x4*)(VT + (size_t)row * MT + col0 + bj * HALF) = pack8(acc[ai][bj][m][0], acc[ai][bj][m][1]); }
            return;
        }
        bf16_t* base = (u.pn < 4) ? Q1 : K1; const int colt = (u.pn & 3) * 256; const float sc = (u.pn < 4) ? ATT_C2 : 1.f; const bool rot = u.pm < ML / 256;
        const int row0 = u.pm * BM + wr * 64 + fr, col0 = colt + wc * 32 + 8 * fq;
#pragma unroll
        for (int ai = 0; ai < 2; ++ai)
#pragma unroll
            for (int m = 0; m < 4; ++m) { const int row = row0 + ai * HALF + m * 16; const int pos = row & (SEQL - 1);
#pragma unroll
                for (int bj = 0; bj < 2; ++bj) { f32x4 v0 = acc[ai][bj][m][0], v1 = acc[ai][bj][m][1]; const int c = col0 + bj * HALF;
                    if (rot) { const f32x4* cs = (const f32x4*)(diffcs + ((size_t)pos * 32 + ((c & 63) >> 1)) * 2); rot8(v0, v1, cs[0], cs[1]); }
                    v0 = v0 * sc; v1 = v1 * sc;
                    *(u32x4*)(base + (size_t)row * 1024 + c) = pack8(v0, v1); } }
    }
};
struct EpiGU {
    static constexpr bool PERM = true;
    bf16_t *G, *U;
    __device__ __forceinline__ void operator()(const f32x4 (&acc)[2][2][4][2], const Unit& u, int wr, int wc, int fr, int fq) const {
        bf16_t* base = (u.pn < 11) ? G : U; const int colt = (u.pn < 11 ? u.pn : u.pn - 11) * 256;
        const int row0 = u.pm * BM + wr * 64 + fr, col0 = colt + wc * 32 + 8 * fq;
#pragma unroll
        for (int ai = 0; ai < 2; ++ai)
#pragma unroll
            for (int m = 0; m < 4; ++m) { const int row = row0 + ai * HALF + m * 16;
#pragma unroll
                for (int bj = 0; bj < 2; ++bj) *(u32x4*)(base + (size_t)row * DFF + col0 + bj * HALF) = pack8(acc[ai][bj][m][0], acc[ai][bj][m][1]); }
    }
};
struct EpiRes {
    static constexpr bool PERM = false;
    const float *xinL, *xinC; float *outL, *outC; const float* gate;
    __device__ __forceinline__ void operator()(const f32x4 (&acc)[2][2][4][2], const Unit& u, int wr, int wc, int fr, int fq) const {
        const bool lat = u.pm < ML / 256; const int mr = lat ? (u.pm >> 3) : 16;
        const float* xin = lat ? xinL : xinC - (size_t)ML * D; float* out = lat ? outL : outC - (size_t)ML * D;
        const float* gp = gate + (size_t)mr * 6144;
        const int col0 = u.pn * BM + wc * 32 + 4 * fq;
#pragma unroll
        for (int bj = 0; bj < 2; ++bj)
#pragma unroll
            for (int n = 0; n < 2; ++n) { const int c = col0 + bj * HALF + n * 16; const f32x4 gv = *(const f32x4*)(gp + c);
#pragma unroll
                for (int ai = 0; ai < 2; ++ai)
#pragma unroll
                    for (int m = 0; m < 4; ++m) { const size_t off = (size_t)(u.pm * BM + ai * HALF + wr * 64 + m * 16 + fr) * D + c;
                        const f32x4 xv = *(const f32x4*)(xin + off); *(f32x4*)(out + off) = xv * DEEP_ALPHA + gv * acc[ai][bj][m][n]; } }
    }
};
}
struct Args {
    const float* in[23];
    float* out; unsigned char* ws;
};
struct Ctx {
    LAS unsigned char* lds; int tid, lane, wave, G, vcu, bid;
    const Args* a;
};
#define IN_X 0
#define IN_C 1
#define IN_CTX 2
#define IN_CCTX 3
#define IN_MODW 4
#define IN_MODB 5
#define IN_LNG 6
#define IN_LNB 7
#define IN_EWIN 8
#define IN_ECONV 9
#define IN_EALOG 10
#define IN_EDTB 11
#define IN_ENORMW 12
#define IN_ERETD 13
#define IN_EWOUT 14
#define IN_OWQKV 15
#define IN_OLAM 16
#define IN_OSUBLN 17
#define IN_OWOUT 18
#define IN_FWG 19
#define IN_FWU 20
#define IN_FCONV 21
#define IN_FWD 22

template <class Map>
__device__ __forceinline__ void transpose_item(const float* W, int ldw, int K, bf16_t* WT, LAS float* scr, int item, int nblk, int lane, Map map) {
    const int kb = item / nblk, nb = item % nblk, k0 = 64 * kb, n0 = 32 * nb;
    const int sc = map(n0 + (lane & 31));
#pragma unroll 8
    for (int i = 0; i < 32; ++i) { const int kk = 2 * i + (lane >> 5); scr[kk * 33 + (lane & 31)] = sc >= 0 ? W[(size_t)(k0 + kk) * ldw + sc] : 0.f; }
    asm volatile("s_waitcnt lgkmcnt(0)" ::: "memory");
    const int c = lane & 7;
#pragma unroll
    for (int j = 0; j < 4; ++j) { const int n = (lane >> 3) + 8 * j; const LAS float* s = scr + (8 * c) * 33 + n;
        u32x4 o; o.x = cvtpk(s[0 * 33], s[1 * 33]); o.y = cvtpk(s[2 * 33], s[3 * 33]); o.z = cvtpk(s[4 * 33], s[5 * 33]); o.w = cvtpk(s[6 * 33], s[7 * 33]);
        *(u32x4*)(WT + (size_t)(n0 + n) * K + k0 + 8 * c) = o; }
    asm volatile("s_waitcnt lgkmcnt(0)" ::: "memory");
}
struct MapId { int off; __device__ int operator()(int n) const { return n + off; } };
struct MapWin {
    __device__ int operator()(int n) const {
        if (n < 2048) return n;
        if (n < 3072) { const int t = (n - 2048) >> 9, e = (n - 2048) & 511, hh = e >> 7, w = e & 127, p = w >> 1, s = w & 1; return (t == 0 ? 2064 : 2576) + hh * 128 + p + 64 * s; }
        if (n < 3584) return 3088 + (n - 3072);
        return 3600 + (n - 3584);
    }
};
struct MapQK1 {
    __device__ int operator()(int n) const { const int blk = n >> 6, e = n & 63, p = e >> 1, s = e & 1; return blk * 64 + p + 32 * s; }
};
struct MapGU { __device__ int operator()(int n) const { return n; } };

__device__ __forceinline__ void p0_weights_l0(const Ctx& C) {
    LAS float* scr = (LAS float*)(C.lds + C.wave * 16384);
    const int gw = C.vcu * NWAVES + C.wave, NGW = C.G * NWAVES;
    const Args& A = *C.a; unsigned char* ws = A.ws;
    constexpr int I_IN = 16 * 128, I_OUT = 16 * 32, I_G = 16 * 88, I_D = 44 * 32;
    for (int it = gw; it < I_IN + I_OUT + 2 * I_G + I_D; it += NGW) {
        int r = it;
        if (r < I_IN) { transpose_item(A.in[IN_EWIN], 4112, 1024, (bf16_t*)(ws + WS_WIN), scr, r, 128, C.lane, MapWin{}); continue; } r -= I_IN;
        if (r < I_OUT) { transpose_item(A.in[IN_EWOUT], 1024, 1024, (bf16_t*)(ws + WS_WOUT0), scr, r, 32, C.lane, MapId{0}); continue; } r -= I_OUT;
        if (r < I_G) { transpose_item(A.in[IN_FWG], DFF, 1024, (bf16_t*)(ws + WS_WGU), scr, r, 88, C.lane, MapId{0}); continue; } r -= I_G;
        if (r < I_G) { transpose_item(A.in[IN_FWU], DFF, 1024, (bf16_t*)(ws + WS_WGU) + (size_t)DFF * 1024, scr, r, 88, C.lane, MapId{0}); continue; } r -= I_G;
        transpose_item(A.in[IN_FWD], 1024, DFF, (bf16_t*)(ws + WS_WD), scr, r, 32, C.lane, MapId{0});
    }
}
__device__ __forceinline__ void p_weights_l1(const Ctx& C) {
    LAS float* scr = (LAS float*)(C.lds + C.wave * 16384);
    const int gw = C.vcu * NWAVES + C.wave, NGW = C.G * NWAVES;
    const Args& A = *C.a; unsigned char* ws = A.ws;
    constexpr int I_QK = 16 * 64, I_V = 16 * 32, I_O = 16 * 32, I_G = 16 * 88, I_D = 44 * 32;
    const float* fg = A.in[IN_FWG] + (size_t)1024 * DFF; const float* fu = A.in[IN_FWU] + (size_t)1024 * DFF; const float* fd = A.in[IN_FWD] + (size_t)DFF * 1024;
    for (int it = gw; it < I_QK + I_V + I_O + 2 * I_G + I_D; it += NGW) {
        int r = it;
        if (r < I_QK) { transpose_item(A.in[IN_OWQKV], 3072, 1024, (bf16_t*)(ws + WS_WQK1), scr, r, 64, C.lane, MapQK1{}); continue; } r -= I_QK;
        if (r < I_V) { transpose_item(A.in[IN_OWQKV], 3072, 1024, (bf16_t*)(ws + WS_WV1), scr, r, 32, C.lane, MapId{2048}); continue; } r -= I_V;
        if (r < I_O) { transpose_item(A.in[IN_OWOUT], 1024, 1024, (bf16_t*)(ws + WS_WO1), scr, r, 32, C.lane, MapId{0}); continue; } r -= I_O;
        if (r < I_G) { transpose_item(fg, DFF, 1024, (bf16_t*)(ws + WS_WGU), scr, r, 88, C.lane, MapId{0}); continue; } r -= I_G;
        if (r < I_G) { transpose_item(fu, DFF, 1024, (bf16_t*)(ws + WS_WGU) + (size_t)DFF * 1024, scr, r, 88, C.lane, MapId{0}); continue; } r -= I_G;
        transpose_item(fd, 1024, DFF, (bf16_t*)(ws + WS_WD), scr, r, 32, C.lane, MapId{0});
    }
}
__device__ __forceinline__ void p0_mod(const Ctx& C) {
    const Args& A = *C.a; float* MOD = (float*)(A.ws + WS_MOD);
    LAS float* act = (LAS float*)(C.lds + 65536) + C.wave * (17 * 128);
    LAS float* red = (LAS float*)(C.lds);
    for (int task = C.bid; task < 2 * 96; task += C.G) {
        const int l = task / 96, cg_ = task % 96, col = cg_ * 64 + C.lane, k0 = C.wave * 128;
        for (int e = C.lane; e < 17 * 128; e += 64) { const int r = e >> 7, k = e & 127; const float v = r < 16 ? A.in[IN_C][r * 1024 + k0 + k] : A.in[IN_CCTX][k0 + k]; act[e] = silu_f(v); }
        asm volatile("s_waitcnt lgkmcnt(0)" ::: "memory");
        float acc[17];
#pragma unroll
        for (int r = 0; r < 17; ++r) acc[r] = 0.f;
        const float* wp = A.in[IN_MODW] + ((size_t)l * 1024 + k0) * 6144 + col;
#pragma unroll 4
        for (int k = 0; k < 128; ++k) { const float w = wp[(size_t)k * 6144];
#pragma unroll
            for (int r = 0; r < 17; ++r) acc[r] += act[r * 128 + k] * w; }
#pragma unroll
        for (int r = 0; r < 17; ++r) red[(C.wave * 17 + r) * 64 + C.lane] = acc[r];
        __syncthreads();
        for (int e = C.tid; e < 17 * 64; e += NTHREADS) { const int r = e >> 6, cc = e & 63; float s = 0.f;
#pragma unroll
            for (int w = 0; w < 8; ++w) s += red[(w * 17 + r) * 64 + cc];
            MOD[((size_t)l * 17 + r) * 6144 + cg_ * 64 + cc] = s + A.in[IN_MODB][l * 6144 + cg_ * 64 + cc]; }
        __syncthreads();
    }
}
__device__ __forceinline__ void sincos_rev(float ang, float& c, float& s) {
    const double rev = (double)ang * 0.15915494309189533577; const float fr = (float)(rev - floor(rev));
    s = __builtin_amdgcn_sinf(fr); c = __builtin_amdgcn_cosf(fr);
}
__device__ __forceinline__ void p0_tables(const Ctx& C) {
    const Args& A = *C.a; float* rcs = (float*)(A.ws + WS_RETCS); float* dcs = (float*)(A.ws + WS_DIFFCS);
    const int gt = C.bid * NTHREADS + C.tid, NT = C.G * NTHREADS;
    for (int e = gt; e < 2048 * 64; e += NT) { const int pos = e >> 6, p = e & 63; const float inv = exp2f(-(float)p * (13.287712379549449f / 64.f)); float c, s; sincos_rev((float)pos * inv, c, s); rcs[2 * e] = c; rcs[2 * e + 1] = s; }
    for (int e = gt; e < 2048 * 32; e += NT) { const int pos = e >> 5, p = e & 31; const float inv = exp2f(-(float)(p & 15) * (13.287712379549449f / 16.f));
        const float pp = (float)(p < 16 ? (pos >> 6) : (pos & 63)); float c, s; sincos_rev(pp * inv, c, s); dcs[2 * e] = c; dcs[2 * e + 1] = s; }
    if (gt == 0) { const float* lp = A.in[IN_OLAM]; float s01 = 0.f, s23 = 0.f; for (int i = 0; i < 64; ++i) { s01 += lp[i] * lp[64 + i]; s23 += lp[128 + i] * lp[192 + i]; }
        ((float*)(A.ws + WS_CTL))[0] = __expf(s01) - __expf(s23) + LAMBDA_INIT1; }
}

__device__ __forceinline__ void p1_modulate_ab(const Ctx& C) {
    const Args& A = *C.a; const float* MOD = (const float*)(A.ws + WS_MOD); bf16_t* H = (bf16_t*)(A.ws + WS_H); float* AB = (float*)(A.ws + WS_AB);
    LAS float* wab = (LAS float*)C.lds;
    for (int e = C.tid; e < 16 * 1024; e += NTHREADS) { const int k = e >> 4, j = e & 15; wab[j * 1024 + k] = A.in[IN_EWIN][(size_t)k * 4112 + 2048 + j]; }
    __syncthreads();
    const int gw = C.vcu * NWAVES + C.wave, NGW = C.G * NWAVES;
    for (int row = gw; row < MT; row += NGW) {
        const bool lat = row < ML; const float* xr = lat ? A.in[IN_X] + (size_t)row * D : A.in[IN_CTX] + (size_t)(row - ML) * D;
        const float* mp = MOD + (size_t)(lat ? (row >> 11) : 16) * 6144;
        f32x4 hv[4];
#pragma unroll
        for (int j = 0; j < 4; ++j) { const int c = 4 * C.lane + 256 * j; const f32x4 xv = *(const f32x4*)(xr + c), sh = *(const f32x4*)(mp + c), sc = *(const f32x4*)(mp + 1024 + c);
            hv[j] = xv * (sc + 1.f) + sh; u32x2 w; w.x = cvtpk(hv[j][0], hv[j][1]); w.y = cvtpk(hv[j][2], hv[j][3]); *(u32x2*)(H + (size_t)row * D + c) = w; }
        float mine = 0.f;
#pragma unroll 2
        for (int q = 0; q < 16; ++q) { float s = 0.f;
#pragma unroll
            for (int j = 0; j < 4; ++j) { const f32x4 w = *(const LAS f32x4*)(wab + q * 1024 + 4 * C.lane + 256 * j); s += hv[j][0] * w[0] + hv[j][1] * w[1] + hv[j][2] * w[2] + hv[j][3] * w[3]; }
            s = wave_sum(s); mine = (C.lane == q) ? s : mine; }
        if (C.lane < 16) AB[(size_t)row * 16 + C.lane] = mine;
    }
    __syncthreads();
}
__device__ __forceinline__ void p_ln(const Ctx& C, int nrows, const float* lng, const float* lnb, const float* modbase  , int shoff, int scoff, bool want_h) {
    const Args& A = *C.a; bf16_t* H = (bf16_t*)(A.ws + WS_H);
    const int gw = C.vcu * NWAVES + C.wave, NGW = C.G * NWAVES;
    f32x4 gv[4], bv[4];
#pragma unroll
    for (int j = 0; j < 4; ++j) { const int c = 4 * C.lane + 256 * j; gv[j] = *(const f32x4*)(lng + c); bv[j] = *(const f32x4*)(lnb + c); }
    for (int row = gw; row < nrows; row += NGW) {
        const bool lat = row < ML; float* xr = lat ? A.out + (size_t)row * D : (float*)(A.ws + WS_XRC) + (size_t)(row - ML) * D;
        f32x4 v[4]; float s = 0.f;
#pragma unroll
        for (int j = 0; j < 4; ++j) { v[j] = *(const f32x4*)(xr + 4 * C.lane + 256 * j); s += (v[j][0] + v[j][1]) + (v[j][2] + v[j][3]); }
        const float mean = wave_sum(s) * (1.f / D); float s2 = 0.f;
#pragma unroll
        for (int j = 0; j < 4; ++j) { v[j] = v[j] - mean; s2 += (v[j][0] * v[j][0] + v[j][1] * v[j][1]) + (v[j][2] * v[j][2] + v[j][3] * v[j][3]); }
        const float rstd = rsqrtf(wave_sum(s2) * (1.f / D) + LN_EPS);
        const float* mp = modbase ? modbase + (size_t)(lat ? (row >> 11) : 16) * 6144 : nullptr;
#pragma unroll
        for (int j = 0; j < 4; ++j) { const int c = 4 * C.lane + 256 * j; const f32x4 y = v[j] * rstd * gv[j] + bv[j]; *(f32x4*)(xr + c) = y;
            if (want_h) { const f32x4 sh = *(const f32x4*)(mp + shoff + c), sc = *(const f32x4*)(mp + scoff + c); const f32x4 h = y * (sc + 1.f) + sh;
                u32x2 w; w.x = cvtpk(h[0], h[1]); w.y = cvtpk(h[2], h[3]); *(u32x2*)(H + (size_t)row * D + c) = w; } }
    }
}
__device__ __forceinline__ void p5_finish(const Ctx& C) {
    const Args& A = *C.a; bf16_t* Y = (bf16_t*)(A.ws + WS_H);
    const bf16_t* O0 = (const bf16_t*)A.out; const bf16_t* O1 = O0 + (size_t)MT * 512; const bf16_t* O2 = O1 + (size_t)MT * 512; const bf16_t* O3 = (const bf16_t*)(A.ws + WS_O3);
    const bf16_t* Z = (const bf16_t*)(A.ws + WS_Z); const bf16_t* RG = (const bf16_t*)(A.ws + WS_RG);
    const int gw = C.vcu * NWAVES + C.wave, NGW = C.G * NWAVES;
    const int kind = C.lane >> 5, c0 = (C.lane & 31) * 16;
    float nw[16];
#pragma unroll
    for (int e = 0; e < 16; ++e) nw[e] = A.in[IN_ENORMW][(c0 & 127) + e];
    for (int row = gw; row < MT; row += NGW) {
        const bf16_t* pa = (kind ? O2 : O0) + (size_t)row * 512 + c0; const bf16_t* pb = (kind ? O3 : O1) + (size_t)row * 512 + c0; const bf16_t* pg = (kind ? RG : Z) + (size_t)row * 512 + c0;
        float o[16], gt[16];
#pragma unroll
        for (int q = 0; q < 2; ++q) { const u32x4 a = *(const u32x4*)(pa + 8 * q), b = *(const u32x4*)(pb + 8 * q), g = *(const u32x4*)(pg + 8 * q);
#pragma unroll
            for (int e = 0; e < 4; ++e) { o[8 * q + 2 * e] = bflo(a[e]) + bflo(b[e]); o[8 * q + 2 * e + 1] = bfhi(a[e]) + bfhi(b[e]); gt[8 * q + 2 * e] = bflo(g[e]); gt[8 * q + 2 * e + 1] = bfhi(g[e]); } }
        float s = 0.f, ss = 0.f;
#pragma unroll
        for (int e = 0; e < 16; ++e) { s += o[e]; }
        s += __shfl_xor(s, 1); s += __shfl_xor(s, 2); s += __shfl_xor(s, 4);
        const float mu = kind ? s * (1.f / 128.f) : 0.f;
#pragma unroll
        for (int e = 0; e < 16; ++e) { o[e] -= mu; ss += o[e] * o[e]; }
        ss += __shfl_xor(ss, 1); ss += __shfl_xor(ss, 2); ss += __shfl_xor(ss, 4);
        const float rn = rsqrtf(ss * (1.f / 128.f) + NORM_EPS);
        u32x4 w[2];
#pragma unroll
        for (int q = 0; q < 2; ++q)
#pragma unroll
            for (int e = 0; e < 4; ++e) { const int i0 = 8 * q + 2 * e; const float y0 = o[i0] * rn * (kind ? 1.f : nw[i0]) * silu_f(gt[i0]), y1 = o[i0 + 1] * rn * (kind ? 1.f : nw[i0 + 1]) * silu_f(gt[i0 + 1]); w[q][e] = cvtpk(y0, y1); }
        bf16_t* yp = Y + (size_t)row * D + kind * 512 + c0;
        *(u32x4*)(yp) = w[0]; *(u32x4*)(yp + 8) = w[1];
    }
}
__device__ __forceinline__ f32x4 ld4bf(const bf16_t* p) { const u32x2 w = *(const u32x2*)p; return (f32x4){bflo(w.x), bfhi(w.x), bflo(w.y), bfhi(w.y)}; }
__device__ __forceinline__ void p_conv(const Ctx& C, int li, bool with_ctx) {
    const Args& A = *C.a; const bf16_t* G = (const bf16_t*)(A.ws + WS_G); bf16_t* U = (bf16_t*)(A.ws + WS_U);
    const float* cw = A.in[IN_FCONV] + (size_t)li * 9 * DFF;
    const int gw = C.vcu * NWAVES + C.wave, NGW = C.G * NWAVES;
    const int ntask = (NB * 32 + (with_ctx ? NB * 4 : 0)) * 11;
    for (int task = gw; task < ntask; task += NGW) {
        const int cb = task % 11, st = task / 11; const int ch0 = cb * 256 + C.lane * 4;
        int tok0, W, c_start; bool up, dn;
        if (st < NB * 32) { const int b = st >> 5, rr = st & 31; tok0 = b * SEQL + rr * 64; W = 64; c_start = 0; up = rr > 0; dn = rr < 31; }
        else { const int s2 = st - NB * 32, b = s2 >> 2, sg = s2 & 3; tok0 = ML + b * CTXL + sg * 64; W = 256; c_start = sg * 64; up = false; dn = false; }
        f32x4 w[9];
#pragma unroll
        for (int q = 0; q < 9; ++q) w[q] = *(const f32x4*)(cw + q * DFF + ch0);
        const f32x4 zero = {0.f, 0.f, 0.f, 0.f};
        const bf16_t* gp = G + (size_t)tok0 * DFF + ch0;
        f32x4 P[3], Cc[3], N[3];
#define LDCOL(dst, cc) do { const int c_ = (cc); const bool ok_ = (c_start + c_) >= 0 && (c_start + c_) < W; const bf16_t* q_ = gp + (ptrdiff_t)c_ * DFF; \
        dst[0] = (ok_ && up) ? ld4bf(q_ - (ptrdiff_t)64 * DFF) : zero; dst[1] = ok_ ? ld4bf(q_) : zero; dst[2] = (ok_ && dn) ? ld4bf(q_ + (ptrdiff_t)64 * DFF) : zero; } while (0)
        LDCOL(P, -1); LDCOL(Cc, 0); LDCOL(N, 1);
        for (int cc = 0; cc < 64; ++cc) {
            f32x4 NN[3]; LDCOL(NN, cc + 2);
            bf16_t* up_ = U + (size_t)(tok0 + cc) * DFF + ch0; const f32x4 uv = ld4bf(up_);
            f32x4 a = zero;
#pragma unroll
            for (int di = 0; di < 3; ++di) a += w[di * 3 + 0] * P[di] + w[di * 3 + 1] * Cc[di] + w[di * 3 + 2] * N[di];
            u32x2 o; o.x = cvtpk(silu_f(a[0]) * uv[0], silu_f(a[1]) * uv[1]); o.y = cvtpk(silu_f(a[2]) * uv[2], silu_f(a[3]) * uv[3]); *(u32x2*)up_ = o;
#pragma unroll
            for (int di = 0; di < 3; ++di) { P[di] = Cc[di]; Cc[di] = N[di]; N[di] = NN[di]; }
        }
#undef LDCOL
    }
}
namespace scan {
constexpr int LDK = 136, LDC = 72;
constexpr int S_ST = 0, S_K = 34816, S_Q = 52224, S_ACOL = 69632, S_QKM = 86016, S_TM = 95232, S_KBG = 104448, S_VB = 122880, S_CW = 141312, S_GS = 145920, S_BS = 146176;
constexpr int R_QD = 69632, R_KDT = 87040, R_VT = 105472, R_PM = 123904;
static_assert(S_BS + 256 <= LDS_BYTES && R_PM + 9216 <= LDS_BYTES, "scan LDS map");
#define MFMA32(a, b, c) __builtin_amdgcn_mfma_f32_32x32x16_bf16((a), (b), (c), 0, 0, 0)
template <int KS>
__device__ __forceinline__ void mm(f32x16& acc, const LAS bf16_t* A, int lda, const LAS bf16_t* Bt, int ldb, int lane) {
    const LAS bf16_t* pa = A + (lane & 31) * lda + 8 * (lane >> 5); const LAS bf16_t* pb = Bt + (lane & 31) * ldb + 8 * (lane >> 5);
#pragma unroll
    for (int ks = 0; ks < KS; ++ks) { const bf16x8 a = *(const LAS bf16x8*)(pa + 16 * ks); const bf16x8 b = *(const LAS bf16x8*)(pb + 16 * ks); acc = MFMA32(a, b, acc); }
}
__device__ __forceinline__ f32x16 zero16() { f32x16 z;
#pragma unroll
    for (int i = 0; i < 16; ++i) z[i] = 0.f; return z; }
__device__ __forceinline__ void unpack16(const u32x4 a, const u32x4 b, float (&f)[16]) {
#pragma unroll
    for (int e = 0; e < 4; ++e) { f[2 * e] = bflo(a[e]); f[2 * e + 1] = bfhi(a[e]); f[8 + 2 * e] = bflo(b[e]); f[8 + 2 * e + 1] = bfhi(b[e]); }
}
__device__ __forceinline__ void st16(LAS bf16_t* p, const float (&f)[16], float s) {
    u32x4 a, b;
#pragma unroll
    for (int e = 0; e < 4; ++e) { a[e] = cvtpk(f[2 * e] * s, f[2 * e + 1] * s); b[e] = cvtpk(f[8 + 2 * e] * s, f[8 + 2 * e + 1] * s); }
    *(LAS u32x4*)p = a; *(LAS u32x4*)(p + 8) = b;
}
__device__ __forceinline__ void conv16(float (&y)[16], const bf16_t* p, bool okm, bool okp, const LAS float* cw) {
    const u32x4 z = {0u, 0u, 0u, 0u};
    const u32x4 c0 = *(const u32x4*)p, c1 = *(const u32x4*)(p + 8);
    const u32x4 m0 = okm ? *(const u32x4*)(p - 1536) : z, m1 = okm ? *(const u32x4*)(p - 1536 + 8) : z;
    const u32x4 p0 = okp ? *(const u32x4*)(p + 1536) : z, p1 = okp ? *(const u32x4*)(p + 1536 + 8) : z;
    float xm[16], xc[16], xp[16]; unpack16(m0, m1, xm); unpack16(c0, c1, xc); unpack16(p0, p1, xp);
#pragma unroll
    for (int e = 0; e < 16; ++e) { const float a = xm[e] * cw[e] + xc[e] * cw[384 + e] + xp[e] * cw[768 + e]; y[e] = silu_f(a); }
}
__device__ __forceinline__ float dppA0(float v) { return __builtin_bit_cast(float, __builtin_amdgcn_mov_dpp(__builtin_bit_cast(int, v), 0xA0, 0xF, 0xF, true)); }
__device__ __forceinline__ float dppF5(float v) { return __builtin_bit_cast(float, __builtin_amdgcn_mov_dpp(__builtin_bit_cast(int, v), 0xF5, 0xF, 0xF, true)); }

__device__ __forceinline__ void dn_chain(const Ctx& C, int b, int h, int dir) {
    const Args& A = *C.a;
#define DN_PTRS(lds) LAS bf16_t* St = (LAS bf16_t*)((lds) + S_ST); LAS bf16_t* Kt = (LAS bf16_t*)((lds) + S_K); LAS bf16_t* Qt = (LAS bf16_t*)((lds) + S_Q); \
    LAS float* Acol = (LAS float*)((lds) + S_ACOL); LAS bf16_t* QKm = (LAS bf16_t*)((lds) + S_QKM); LAS bf16_t* Tm = (LAS bf16_t*)((lds) + S_TM); \
    LAS bf16_t* KBG = (LAS bf16_t*)((lds) + S_KBG); LAS bf16_t* VB = (LAS bf16_t*)((lds) + S_VB); LAS float* CW = (LAS float*)((lds) + S_CW); \
    LAS float* GS = (LAS float*)((lds) + S_GS); LAS float* BS = (LAS float*)((lds) + S_BS);
    const bf16_t* QKVR = (const bf16_t*)(A.ws + WS_QKVR); const float* AB = (const float*)(A.ws + WS_AB);
    bf16_t* OUT = (bf16_t*)A.out + (size_t)dir * MT * 512;
    const int tid0 = C.tid, wid = C.wave, lane0 = C.lane;
    { DN_PTRS(C.lds) const int tid = tid0;
    for (int e = tid; e < 1152; e += NTHREADS) { const int tap = e / 384, rem = e % 384, seg = rem >> 7, ee = rem & 127; CW[e] = A.in[IN_ECONV][tap * 1536 + seg * 512 + h * 128 + ee]; }
    for (int e = tid; e < 8704; e += NTHREADS) ((LAS unsigned*)St)[e] = 0u; (void)Kt; (void)Qt; (void)Acol; (void)QKm; (void)Tm; (void)KBG; (void)VB; (void)GS; (void)BS; }
    f32x16 accS[2]; accS[0] = zero16(); accS[1] = zero16();
    const float Aexp = __expf(A.in[IN_EALOG][dir * 4 + h]), dtb = A.in[IN_EDTB][dir * 4 + h];
    const int mt = wid >> 2, nt = wid & 3;
    __syncthreads();
    for (int n = 0; n < 36; ++n) {
        int zoff = 0; asm volatile("" : "+s"(zoff));
        LAS unsigned char* lds = C.lds + zoff; DN_PTRS(lds)
        const int tid = tid0 + zoff, lane = lane0 + zoff, r = lane & 31, hh = lane >> 5, ti = tid >> 3, tj = tid & 7;
        int seq0, Lseq, cidx;
        if (n < 4) { cidx = dir ? 3 - n : n; seq0 = ML + b * CTXL; Lseq = CTXL; } else { const int m_ = n - 4; cidx = dir ? 31 - m_ : m_; seq0 = b * SEQL; Lseq = SEQL; }
        const int base = seq0 + cidx * 64;
        if (wid == 0) {
            const int row = base + (dir ? 63 - lane : lane);
            const float av = AB[(size_t)row * 16 + dir * 4 + h] + dtb, bv = AB[(size_t)row * 16 + 8 + dir * 4 + h];
            const float sp = av > 20.f ? av : log1pf(__expf(av));
            float la = -Aexp * sp;
#pragma unroll
            for (int d = 1; d < 64; d <<= 1) { const float t = __shfl_up(la, d); if (lane >= d) la += t; }
            GS[lane] = la; BS[lane] = sigmoid_f(bv);
        }
        float q[16], k[16], v[16];
        {
            const int tokrow = base + (dir ? 63 - ti : ti); const bool okm = tokrow - 1 >= seq0, okp = tokrow + 1 < seq0 + Lseq;
            const bf16_t* p = QKVR + (size_t)tokrow * 1536 + h * 128 + tj * 16;
            conv16(q, p, okm, okp, CW + tj * 16); asm volatile("" ::: "memory"); conv16(k, p + 512, okm, okp, CW + 128 + tj * 16); asm volatile("" ::: "memory"); conv16(v, p + 1024, okm, okp, CW + 256 + tj * 16);
            float sq = 0.f, sk = 0.f;
#pragma unroll
            for (int e = 0; e < 16; ++e) { sq += q[e] * q[e]; sk += k[e] * k[e]; }
            sq += __shfl_xor(sq, 1); sq += __shfl_xor(sq, 2); sq += __shfl_xor(sq, 4);
            sk += __shfl_xor(sk, 1); sk += __shfl_xor(sk, 2); sk += __shfl_xor(sk, 4);
            const float rq = rsqrtf(sq + NORM_EPS) * 0.088388347648318447f, rk = rsqrtf(sk + NORM_EPS);
#pragma unroll
            for (int e = 0; e < 16; ++e) { q[e] *= rq; k[e] *= rk; }
        }
        __syncthreads();
        const float g_i = GS[ti], beta_i = BS[ti], g_last = GS[63]; const float eg = __expf(g_i);
        st16(Kt + ti * LDK + tj * 16, k, 1.f); st16(Qt + ti * LDK + tj * 16, q, 1.f);
        { const float sb = beta_i * eg;
#pragma unroll
          for (int e = 0; e < 16; ++e) { KBG[(tj * 16 + e) * LDC + ti] = f2bf(k[e] * sb); VB[(tj * 16 + e) * LDC + ti] = f2bf(v[e] * beta_i); } }
        __syncthreads();
        {
            const int w4 = wid & 3, cm = w4 >> 1, cn = w4 & 1;
            if (!(cm == 0 && cn == 1)) {
                f32x16 acc = zero16();
                mm<8>(acc, (wid < 4 ? Kt : Qt) + 32 * cm * LDK, LDK, Kt + 32 * cn * LDK, LDK, lane);
                const int jj = 32 * cn + r; const float gj = GS[jj];
#pragma unroll
                for (int reg = 0; reg < 16; ++reg) { const int ii = 32 * cm + crow(reg, hh); const float dec = __expf(fminf(GS[ii] - gj, 0.f));
                    if (wid < 4) { if (ii > jj) Acol[jj * 64 + (ii & 1) * 32 + (ii >> 1)] = BS[ii] * acc[reg] * dec; }
                    else QKm[ii * LDC + jj] = f2bf(ii >= jj ? acc[reg] * dec : 0.f); }
            } else if (wid >= 4) {
#pragma unroll
                for (int reg = 0; reg < 16; ++reg) QKm[crow(reg, hh) * LDC + 32 + r] = 0;
            }
        }
        __syncthreads();
        st16(Qt + ti * LDK + tj * 16, q, eg);
#ifndef NO_TSOLVE
        if (wid < 2) {
            const int col = tid >> 1, p = tid & 1; const LAS float* ap = Acol + p * 32;
            float x[32];
#pragma unroll
            for (int ii = 0; ii < 32; ++ii) x[ii] = (2 * ii + p == col) ? 1.f : 0.f;
#pragma unroll
            for (int j = 0; j < 63; ++j) {
                const float xv = x[j >> 1]; const float xj = (j & 1) ? dppF5(xv) : dppA0(xv);
                if ((j & 1) == 0) { const float a0 = ap[j * 64 + (j >> 1)]; x[j >> 1] -= (p == 1) ? a0 * xj : 0.f; }
#pragma unroll
                for (int ii = (j >> 1) + 1; ii < 32; ++ii) x[ii] -= ap[j * 64 + ii] * xj;
                asm volatile("" ::: "memory");
            }
#pragma unroll
            for (int ii = 0; ii < 32; ++ii) Tm[(2 * ii + p) * LDC + col] = f2bf(x[ii]);
        }
#endif
        __syncthreads();
        f32x16 uacc = zero16();
        {
            mm<4>(uacc, Tm + 32 * mt * LDC, LDC, VB + 32 * nt * LDC, LDC, lane);
            f32x16 wacc = zero16(); mm<4>(wacc, Tm + 32 * mt * LDC, LDC, KBG + 32 * nt * LDC, LDC, lane);
#pragma unroll
            for (int reg = 0; reg < 16; ++reg) Kt[(32 * mt + crow(reg, hh)) * LDK + 32 * nt + r] = f2bf(-wacc[reg]);
        }
        __syncthreads();
        {
            mm<8>(uacc, Kt + 32 * mt * LDK, LDK, St + 32 * nt * LDK, LDK, lane);
#pragma unroll
            for (int q4 = 0; q4 < 4; ++q4) { u32x2 w; w.x = cvtpk(uacc[4 * q4], uacc[4 * q4 + 1]); w.y = cvtpk(uacc[4 * q4 + 2], uacc[4 * q4 + 3]);
                *(LAS u32x2*)(KBG + (32 * nt + r) * LDC + 32 * mt + 8 * q4 + 4 * hh) = w; }
            const float ek = __expf(g_last - g_i);
#pragma unroll
            for (int e = 0; e < 16; ++e) VB[(tj * 16 + e) * LDC + ti] = f2bf(k[e] * ek);
        }
        const float cd = __expf(g_last);
        __syncthreads();
        {
            f32x16 oacc = zero16();
            mm<8>(oacc, Qt + 32 * mt * LDK, LDK, St + 32 * nt * LDK, LDK, lane);
            mm<4>(oacc, QKm + 32 * mt * LDC, LDC, KBG + 32 * nt * LDC, LDC, lane);
#pragma unroll
            for (int reg = 0; reg < 16; ++reg) { const int ii = 32 * mt + crow(reg, hh); const int row = base + (dir ? 63 - ii : ii);
                OUT[(size_t)row * 512 + h * 128 + 32 * nt + r] = f2bf(oacc[reg]); }
#pragma unroll
            for (int t = 0; t < 2; ++t) { const int kt = mt * 2 + t; accS[t] = accS[t] * cd; mm<4>(accS[t], VB + 32 * kt * LDC, LDC, KBG + 32 * nt * LDC, LDC, lane); }
        }
        __syncthreads();
#pragma unroll
        for (int t = 0; t < 2; ++t) { const int kt = mt * 2 + t;
#pragma unroll
            for (int q4 = 0; q4 < 4; ++q4) { u32x2 w; w.x = cvtpk(accS[t][4 * q4], accS[t][4 * q4 + 1]); w.y = cvtpk(accS[t][4 * q4 + 2], accS[t][4 * q4 + 3]);
                *(LAS u32x2*)(St + (32 * nt + r) * LDK + 32 * kt + 8 * q4 + 4 * hh) = w; } }
    }
    __syncthreads();
}

__device__ __forceinline__ void ret_chain(const Ctx& C, int b, int h, int dir) {
    const Args& A = *C.a;
#define RET_PTRS(lds) LAS bf16_t* St = (LAS bf16_t*)((lds) + S_ST); LAS bf16_t* Kt = (LAS bf16_t*)((lds) + S_K); LAS bf16_t* Qt = (LAS bf16_t*)((lds) + S_Q); \
    LAS bf16_t* QD = (LAS bf16_t*)((lds) + R_QD); LAS bf16_t* KDt = (LAS bf16_t*)((lds) + R_KDT); LAS bf16_t* Vt = (LAS bf16_t*)((lds) + R_VT); LAS bf16_t* Pm = (LAS bf16_t*)((lds) + R_PM);
    const bf16_t* RQ = (const bf16_t*)(A.ws + WS_RQ); const bf16_t* RK = (const bf16_t*)(A.ws + WS_RK); const bf16_t* RV = (const bf16_t*)(A.ws + WS_RV);
    bf16_t* OUT = dir == 0 ? (bf16_t*)A.out + (size_t)2 * MT * 512 : (bf16_t*)(A.ws + WS_O3);
    const int tid0 = C.tid, wid = C.wave, lane0 = C.lane;
    for (int e = tid0; e < 8704; e += NTHREADS) ((LAS unsigned*)(C.lds + S_ST))[e] = 0u;
    f32x16 accS[2]; accS[0] = zero16(); accS[1] = zero16();
    const float lg = -__expf(A.in[IN_ERETD][dir * 4 + h]);
    const float cdec = __expf(lg * 64.f), eqi = __expf(lg * (float)((tid0 >> 3) + 1)), eki = __expf(lg * (float)(63 - (tid0 >> 3)));
    const int mt = wid >> 2, nt = wid & 3;
    __syncthreads();
    for (int n = 0; n < 36; ++n) {
        int zoff = 0; asm volatile("" : "+s"(zoff));
        LAS unsigned char* lds = C.lds + zoff; RET_PTRS(lds)
        const int tid = tid0 + zoff, lane = lane0 + zoff, r = lane & 31, hh = lane >> 5, ti = tid >> 3, tj = tid & 7;
        int seq0, cidx;
        if (n < 4) { cidx = dir ? 3 - n : n; seq0 = ML + b * CTXL; } else { const int m_ = n - 4; cidx = dir ? 31 - m_ : m_; seq0 = b * SEQL; }
        const int base = seq0 + cidx * 64;
        {
            const int tokrow = base + (dir ? 63 - ti : ti); const size_t off = (size_t)tokrow * 512 + h * 128 + tj * 16;
            float q[16], k[16], v[16];
            unpack16(*(const u32x4*)(RQ + off), *(const u32x4*)(RQ + off + 8), q); unpack16(*(const u32x4*)(RK + off), *(const u32x4*)(RK + off + 8), k); unpack16(*(const u32x4*)(RV + off), *(const u32x4*)(RV + off + 8), v);
            st16(Qt + ti * LDK + tj * 16, q, 1.f); st16(Kt + ti * LDK + tj * 16, k, 1.f); st16(QD + ti * LDK + tj * 16, q, eqi);
#pragma unroll
            for (int e = 0; e < 16; ++e) { KDt[(tj * 16 + e) * LDC + ti] = f2bf(k[e] * eki); Vt[(tj * 16 + e) * LDC + ti] = f2bf(v[e]); }
        }
        __syncthreads();
        if (wid < 4) {
            const int cm = wid >> 1, cn = wid & 1;
            if (!(cm == 0 && cn == 1)) {
                f32x16 acc = zero16(); mm<8>(acc, Qt + 32 * cm * LDK, LDK, Kt + 32 * cn * LDK, LDK, lane);
                const int jj = 32 * cn + r;
#pragma unroll
                for (int reg = 0; reg < 16; ++reg) { const int ii = 32 * cm + crow(reg, hh); Pm[ii * LDC + jj] = f2bf(ii >= jj ? acc[reg] * __expf(lg * (float)(ii - jj)) : 0.f); }
            } else {
#pragma unroll
                for (int reg = 0; reg < 16; ++reg) Pm[crow(reg, hh) * LDC + 32 + r] = 0;
            }
        }
        __syncthreads();
        {
            f32x16 oacc = zero16();
            mm<4>(oacc, Pm + 32 * mt * LDC, LDC, Vt + 32 * nt * LDC, LDC, lane);
            mm<8>(oacc, QD + 32 * mt * LDK, LDK, St + 32 * nt * LDK, LDK, lane);
#pragma unroll
            for (int reg = 0; reg < 16; ++reg) { const int ii = 32 * mt + crow(reg, hh); const int row = base + (dir ? 63 - ii : ii);
                OUT[(size_t)row * 512 + h * 128 + 32 * nt + r] = f2bf(oacc[reg]); }
#pragma unroll
            for (int t = 0; t < 2; ++t) { const int kt = mt * 2 + t; accS[t] = accS[t] * cdec; mm<4>(accS[t], KDt + 32 * kt * LDC, LDC, Vt + 32 * nt * LDC, LDC, lane); }
        }
        __syncthreads();
#pragma unroll
        for (int t = 0; t < 2; ++t) { const int kt = mt * 2 + t;
#pragma unroll
            for (int q4 = 0; q4 < 4; ++q4) { u32x2 w; w.x = cvtpk(accS[t][4 * q4], accS[t][4 * q4 + 1]); w.y = cvtpk(accS[t][4 * q4 + 2], accS[t][4 * q4 + 3]);
                *(LAS u32x2*)(St + (32 * nt + r) * LDK + 32 * kt + 8 * q4 + 4 * hh) = w; } }
    }
    __syncthreads();
}
__device__ __forceinline__ void p_scan(const Ctx& C) {
    for (int ch = C.bid; ch < 256; ch += C.G) {
        const int kind = ch >> 7, rest = ch & 127, b = rest >> 3, h = (rest >> 1) & 3, dir = rest & 1;

#ifndef NO_DN
        if (kind == 0) dn_chain(C, b, h, dir);
#endif
#ifndef NO_RET
        if (kind == 1) ret_chain(C, b, h, dir);
#endif
    }
}
}
namespace attn {
constexpr int LDT = 72;
constexpr int KS_BYTES = 64 * LDT * 2, VS_BYTES = 128 * LDT * 2, STAGE = 2 * KS_BYTES + VS_BYTES;
constexpr int EX_OFF = 0, YST_OFF = 81920;
static_assert(2 * STAGE <= YST_OFF && YST_OFF + 4 * 32 * 136 * 2 <= LDS_BYTES, "attn LDS map");
#define MFMA32(a, b, c) __builtin_amdgcn_mfma_f32_32x32x16_bf16((a), (b), (c), 0, 0, 0)
__device__ __forceinline__ void p_attn(const Ctx& C) {
    const Args& A = *C.a; LAS unsigned char* lds = C.lds;
    const bf16_t* Q1 = (const bf16_t*)(A.ws + WS_Q1); const bf16_t* K1 = (const bf16_t*)(A.ws + WS_K1); const bf16_t* VT = (const bf16_t*)(A.ws + WS_VT); bf16_t* Y1 = (bf16_t*)(A.ws + WS_Y1);
    const float lam = ((const float*)(A.ws + WS_CTL))[0];
    const int tid = C.tid, wid = C.wave, lane = C.lane, r = lane & 31, hh = lane >> 5, comp = wid & 1, qs = wid >> 1;
    for (int unit = C.vcu; unit < NB * 8 * 16; unit += C.G) {
        const int bh = unit >> 4, qb = unit & 15, b = bh >> 3, hd = bh & 7;
        const int qrow0 = b * SEQL + qb * 128 + qs * 32;
        bf16x8 qr[4];
#pragma unroll
        for (int ks = 0; ks < 4; ++ks) qr[ks] = *(const bf16x8*)(Q1 + (size_t)(qrow0 + r) * 1024 + hd * 128 + comp * 64 + 16 * ks + 8 * hh);
        u32x4 st[4];
        auto gload = [&](int kt) {
            const int krow0 = kt < 32 ? b * SEQL + 64 * kt : ML + b * CTXL + 64 * (kt - 32);
#pragma unroll
            for (int i = 0; i < 2; ++i) { const int c = tid + 512 * i; const int key = c >> 4, ch = c & 15; st[i] = *(const u32x4*)(K1 + (size_t)(krow0 + key) * 1024 + hd * 128 + ch * 8); }
#pragma unroll
            for (int i = 0; i < 2; ++i) { const int c = tid + 512 * i; const int dv = c >> 3, ch = c & 7; st[2 + i] = *(const u32x4*)(VT + (size_t)(hd * 128 + dv) * MT + krow0 + ch * 8); }
        };
        auto lstore = [&](int buf) {
            LAS unsigned char* sb = lds + buf * STAGE;
#pragma unroll
            for (int i = 0; i < 2; ++i) { const int c = tid + 512 * i; const int key = c >> 4, ch = c & 15; *(LAS u32x4*)(sb + (ch >> 3) * KS_BYTES + (key * LDT + (ch & 7) * 8) * 2) = st[i]; }
#pragma unroll
            for (int i = 0; i < 2; ++i) { const int c = tid + 512 * i; const int dv = c >> 3, ch = c & 7; *(LAS u32x4*)(sb + 2 * KS_BYTES + (dv * LDT + ch * 8) * 2) = st[2 + i]; }
        };
        gload(0); lstore(0); gload(1);
        float m_run = -1e30f, l_run = 0.f;
        f32x16 o[4];
#pragma unroll
        for (int dt = 0; dt < 4; ++dt)
#pragma unroll
            for (int i = 0; i < 16; ++i) o[dt][i] = 0.f;
        __syncthreads();
        for (int kt = 0; kt < 36; ++kt) {
            const LAS unsigned char* sb = lds + (kt & 1) * STAGE;
            const LAS bf16_t* Ks = (const LAS bf16_t*)(sb + comp * KS_BYTES); const LAS bf16_t* Vs = (const LAS bf16_t*)(sb + 2 * KS_BYTES);
            f32x16 p[2];
#pragma unroll
            for (int kk = 0; kk < 2; ++kk) {
#pragma unroll
                for (int i = 0; i < 16; ++i) p[kk][i] = 0.f;
#pragma unroll
                for (int ks = 0; ks < 4; ++ks) { const bf16x8 a = *(const LAS bf16x8*)(Ks + (32 * kk + r) * LDT + 16 * ks + 8 * hh); p[kk] = MFMA32(a, qr[ks], p[kk]); }
            }
            float mx = p[0][0];
#pragma unroll
            for (int i = 0; i < 16; ++i) { mx = fmaxf(mx, p[0][i]); mx = fmaxf(mx, p[1][i]); }
            mx = fmaxf(mx, __shfl_xor(mx, 32));
            const float m_new = fmaxf(m_run, mx); const float alpha = exp2f(m_run - m_new); m_run = m_new;
            float ls = 0.f;
#pragma unroll
            for (int kk = 0; kk < 2; ++kk)
#pragma unroll
                for (int i = 0; i < 16; ++i) { const float e = exp2f(p[kk][i] - m_new); p[kk][i] = e; ls += e; }
            l_run = l_run * alpha + ls;
#pragma unroll
            for (int dt = 0; dt < 4; ++dt) o[dt] = o[dt] * alpha;
#pragma unroll
            for (int kk = 0; kk < 2; ++kk)
#pragma unroll
                for (int s = 0; s < 2; ++s) {
                    u32x4 pw; pw.x = cvtpk(p[kk][8 * s], p[kk][8 * s + 1]); pw.y = cvtpk(p[kk][8 * s + 2], p[kk][8 * s + 3]); pw.z = cvtpk(p[kk][8 * s + 4], p[kk][8 * s + 5]); pw.w = cvtpk(p[kk][8 * s + 6], p[kk][8 * s + 7]);
                    const bf16x8 pf = __builtin_bit_cast(bf16x8, pw);
#pragma unroll
                    for (int dt = 0; dt < 4; ++dt) {
                        const LAS bf16_t* vp = Vs + (32 * dt + r) * LDT + 32 * kk + 16 * s + 4 * hh;
                        const s16x4 lo = *(const LAS s16x4*)vp, hi = *(const LAS s16x4*)(vp + 8);
                        const bf16x8 vf = __builtin_shufflevector(lo, hi, 0, 1, 2, 3, 4, 5, 6, 7);
                        o[dt] = MFMA32(vf, pf, o[dt]);
                    }
                }
            if (kt + 1 < 36) lstore((kt + 1) & 1);
            if (kt + 2 < 36) gload(kt + 2);
            __syncthreads();
        }
        l_run += __shfl_xor(l_run, 32);
        const float inv = 1.f / l_run;
        LAS float* EX = (LAS float*)(lds + EX_OFF) + qs * 128 * 32;
        if (comp == 1) {
#pragma unroll
            for (int dt = 0; dt < 4; ++dt)
#pragma unroll
                for (int i = 0; i < 16; ++i) EX[(32 * dt + crow(i, hh)) * 32 + r] = o[dt][i] * inv * lam;
        }
        __syncthreads();
        if (comp == 0) {
            float ss = 0.f;
#pragma unroll
            for (int dt = 0; dt < 4; ++dt)
#pragma unroll
                for (int i = 0; i < 16; ++i) { const float v = o[dt][i] * inv - EX[(32 * dt + crow(i, hh)) * 32 + r]; o[dt][i] = v; ss += v * v; }
            ss += __shfl_xor(ss, 32);
            const float rn = rsqrtf(ss * (1.f / 128.f) + NORM_EPS) * (1.f - LAMBDA_INIT1);
            LAS bf16_t* ys = (LAS bf16_t*)(lds + YST_OFF) + qs * 32 * 136;
#pragma unroll
            for (int dt = 0; dt < 4; ++dt)
#pragma unroll
                for (int q4 = 0; q4 < 4; ++q4) { const int dv = 32 * dt + 8 * q4 + 4 * hh; const f32x4 sw = *(const f32x4*)(A.in[IN_OSUBLN] + dv);
                    u32x2 w; w.x = cvtpk(o[dt][4 * q4] * rn * sw[0], o[dt][4 * q4 + 1] * rn * sw[1]); w.y = cvtpk(o[dt][4 * q4 + 2] * rn * sw[2], o[dt][4 * q4 + 3] * rn * sw[3]);
                    *(LAS u32x2*)(ys + r * 136 + dv) = w; }
            asm volatile("s_waitcnt lgkmcnt(0)" ::: "memory");
#pragma unroll
            for (int i = 0; i < 8; ++i) { const int row = i * 4 + (lane >> 4), ch = lane & 15; const u32x4 v = *(const LAS u32x4*)(ys + row * 136 + ch * 8);
                *(u32x4*)(Y1 + (size_t)(qrow0 + row) * 1024 + hd * 128 + ch * 8) = v; }
        }
        __syncthreads();
    }
}
}
__global__ void __launch_bounds__(NTHREADS, 2) fwd_kernel(Args args, int ph_lo, int ph_hi) {
    extern __shared__ __attribute__((aligned(16))) unsigned char lds_raw[];
    cg::grid_group grid = cg::this_grid();
    Ctx C; C.lds = (LAS unsigned char*)lds_raw; C.tid = threadIdx.x; C.lane = C.tid & 63; C.wave = __builtin_amdgcn_readfirstlane(C.tid >> 6);
    C.G = gridDim.x; C.bid = blockIdx.x; C.vcu = (C.G % 8 == 0) ? (C.bid % 8) * (C.G / 8) + C.bid / 8 : C.bid; C.a = &args;
    unsigned char* ws = args.ws;
    const float* MOD0 = (const float*)(ws + WS_MOD); const float* MOD1 = MOD0 + 17 * 6144;
    const float* lng = args.in[IN_LNG]; const float* lnb = args.in[IN_LNB];
    bf16_t* H = (bf16_t*)(ws + WS_H);
    float* XRC = (float*)(ws + WS_XRC);
#ifndef PHMASK
#define PHMASK 0xFFFFFFFFu
#endif
#define IN(k) (((PHMASK >> (k)) & 1u) && ph_lo <= (k) && (k) < ph_hi)
#define SEAM(k) do { if (IN(k) && IN((k) + 1)) grid.sync(); } while (0)
    if (IN(0)) { p0_weights_l0(C); __syncthreads(); p0_mod(C); p0_tables(C); }
    SEAM(0);
    if (IN(1)) p1_modulate_ab(C);
    SEAM(1);
    if (IN(2)) {
        pg8::Order S; S.init(1024, C.G, C.bid, pg8::GemmDesc{H, (const bf16_t*)(ws + WS_WIN), MT / 256, 16});
        epi::EpiIn E{(bf16_t*)(ws + WS_QKVR), (bf16_t*)(ws + WS_Z), (bf16_t*)(ws + WS_RQ), (bf16_t*)(ws + WS_RK), (bf16_t*)(ws + WS_RV), (bf16_t*)(ws + WS_RG), (const float*)(ws + WS_RETCS)};
        pg8::gemm_phase<epi::EpiIn>(C.lds, S, E);
    }
    SEAM(2);
    if (IN(3)) scan::p_scan(C);
    SEAM(3);
    if (IN(4)) p5_finish(C);
    SEAM(4);
    if (IN(5)) {
        pg8::Order S; S.init(1024, C.G, C.bid, pg8::GemmDesc{H, (const bf16_t*)(ws + WS_WOUT0), MT / 256, 4});
        epi::EpiRes E{args.in[IN_X], args.in[IN_CTX], args.out, XRC, MOD0 + 2048};
        pg8::gemm_phase<epi::EpiRes>(C.lds, S, E);
    }
    SEAM(5);
    if (IN(6)) p_ln(C, MT, lng, lnb, MOD0, 3072, 4096, true);
    SEAM(6);
    if (IN(7)) {
        pg8::Order S; S.init(1024, C.G, C.bid, pg8::GemmDesc{H, (const bf16_t*)(ws + WS_WGU), MT / 256, 22});
        epi::EpiGU E{(bf16_t*)(ws + WS_G), (bf16_t*)(ws + WS_U)};
        pg8::gemm_phase<epi::EpiGU>(C.lds, S, E);
    }
    SEAM(7);
    if (IN(8)) p_conv(C, 0, true);
    SEAM(8);
    if (IN(9)) {
        pg8::Order S; S.init(DFF, C.G, C.bid, pg8::GemmDesc{(const bf16_t*)(ws + WS_U), (const bf16_t*)(ws + WS_WD), MT / 256, 4});
        epi::EpiRes E{args.out, XRC, args.out, XRC, MOD0 + 5120};
        pg8::gemm_phase<epi::EpiRes>(C.lds, S, E);
    }
    SEAM(9);
    if (IN(10)) { p_ln(C, MT, lng + 1024, lnb + 1024, MOD1, 0, 1024, true); p_weights_l1(C); }
    SEAM(10);
    if (IN(11)) {
        pg8::Order S; S.init2(1024, C.G, C.bid, pg8::GemmDesc{H, (const bf16_t*)(ws + WS_WQK1), MT / 256, 8}, pg8::GemmDesc{(const bf16_t*)(ws + WS_WV1), H, 4, MT / 256});
        epi::EpiQKV1 E{(bf16_t*)(ws + WS_Q1), (bf16_t*)(ws + WS_K1), (bf16_t*)(ws + WS_VT), (const float*)(ws + WS_DIFFCS)};
        pg8::gemm_phase<epi::EpiQKV1>(C.lds, S, E);
    }
    SEAM(11);
    if (IN(12)) attn::p_attn(C);
    SEAM(12);
    if (IN(13)) {
        pg8::Order S; S.init(1024, C.G, C.bid, pg8::GemmDesc{(const bf16_t*)(ws + WS_Y1), (const bf16_t*)(ws + WS_WO1), ML / 256, 4});
        epi::EpiRes E{args.out, XRC, args.out, XRC, MOD1 + 2048};
        pg8::gemm_phase<epi::EpiRes>(C.lds, S, E);
    }
    SEAM(13);
    if (IN(14)) p_ln(C, ML, lng + 2048, lnb + 2048, MOD1, 3072, 4096, true);
    SEAM(14);
    if (IN(15)) {
        pg8::Order S; S.init(1024, C.G, C.bid, pg8::GemmDesc{H, (const bf16_t*)(ws + WS_WGU), ML / 256, 22});
        epi::EpiGU E{(bf16_t*)(ws + WS_G), (bf16_t*)(ws + WS_U)};
        pg8::gemm_phase<epi::EpiGU>(C.lds, S, E);
    }
    SEAM(15);
    if (IN(16)) p_conv(C, 1, false);
    SEAM(16);
    if (IN(17)) {
        pg8::Order S; S.init(DFF, C.G, C.bid, pg8::GemmDesc{(const bf16_t*)(ws + WS_U), (const bf16_t*)(ws + WS_WD), ML / 256, 4});
        epi::EpiRes E{args.out, XRC, args.out, XRC, MOD1 + 5120};
        pg8::gemm_phase<epi::EpiRes>(C.lds, S, E);
    }
    SEAM(17);
    if (IN(18)) p_ln(C, ML, lng + 3072, lnb + 3072, nullptr, 0, 0, false);
#undef IN
#undef SEAM
}
constexpr int N_PHASES = 19;

extern "C" void kernel_launch(void* const* d_in, const int* in_sizes, int n_in, void* d_out, int out_size, void* d_ws, size_t ws_size, hipStream_t stream) {
    static int grid = 0;
    if (grid == 0) {
        if (n_in != 23 || out_size != ML * D || ws_size < WS_END) { fprintf(stderr, "kernel_launch: unexpected problem shape (n_in %d, out %d, ws %zu)\n", n_in, out_size, ws_size); grid = -1; return; }
        int dev = 0, cus = 0, per_cu = 0;
        hipGetDevice(&dev); hipDeviceGetAttribute(&cus, hipDeviceAttributeMultiprocessorCount, dev);
        hipFuncSetAttribute((const void*)fwd_kernel, hipFuncAttributeMaxDynamicSharedMemorySize, LDS_BYTES);
        hipOccupancyMaxActiveBlocksPerMultiprocessor(&per_cu, (const void*)fwd_kernel, NTHREADS, LDS_BYTES);
        (void)hipGetLastError();
        if (per_cu < 1) { fprintf(stderr, "kernel_launch: occupancy query says %d blocks/CU\n", per_cu); per_cu = 1; }
        grid = cus;
        if (grid > cus * per_cu) grid = cus * per_cu;
    }
    if (grid < 0) return;
    Args a{};
    for (int i = 0; i < 23; ++i) a.in[i] = (const float*)d_in[i];
    a.out = (float*)d_out; a.ws = (unsigned char*)d_ws;
#ifndef MK_SPLIT
    int lo = 0, hi = N_PHASES;
    void* kargs[] = {&a, &lo, &hi};
    hipError_t e = hipLaunchCooperativeKernel((const void*)fwd_kernel, dim3(grid), dim3(NTHREADS), kargs, LDS_BYTES, stream);
    if (e != hipSuccess) fprintf(stderr, "cooperative launch failed: %s (grid %d)\n", hipGetErrorString(e), grid);
#else
    for (int p = 0; p < N_PHASES; ++p) {
        int lo = p, hi = p + 1; void* kargs[] = {&a, &lo, &hi};
        hipError_t e = hipLaunchCooperativeKernel((const void*)fwd_kernel, dim3(grid), dim3(NTHREADS), kargs, LDS_BYTES, stream);
        if (e != hipSuccess) { fprintf(stderr, "cooperative launch %d failed: %s (grid %d)\n", p, hipGetErrorString(e), grid); break; }
    }
#endif
}
```

```cpp
#include <hip/hip_runtime.h>
#include <hip/hip_cooperative_groups.h>
#include <cstdio>
#include <cstdint>
namespace cg = cooperative_groups;

#define LAS __attribute__((address_space(3)))
typedef unsigned short bf16_t;
typedef short bf16x8 __attribute__((ext_vector_type(8)));
typedef short s16x4 __attribute__((ext_vector_type(4)));
typedef float f32x4 __attribute__((ext_vector_type(4)));
typedef float f32x2 __attribute__((ext_vector_type(2)));
typedef float f32x16 __attribute__((ext_vector_type(16)));
typedef unsigned u32x4 __attribute__((ext_vector_type(4)));
typedef unsigned u32x2 __attribute__((ext_vector_type(2)));
typedef __bf16 bf16x2_t __attribute__((ext_vector_type(2)));

constexpr int D = 1024, NB = 16, SEQL = 2048, CTXL = 256;
constexpr int ML = NB * SEQL, MC = NB * CTXL, MT = ML + MC;
constexpr int DFF = 2816;
constexpr int NWAVES = 8, NTHREADS = 512;
constexpr float LN_EPS = 1e-5f, NORM_EPS = 1e-6f;
constexpr float DEEP_ALPHA = 1.41421356237309515f;
constexpr float LAMBDA_INIT1 = 0.8f - 0.6f * 0.74081822068171788f;
constexpr float ATT_C2 = 0.125f * 1.4426950408889634f;

constexpr size_t MiB = 1u << 20;
constexpr size_t WS_CTL = 0;
constexpr size_t WS_MOD = 128 * 1024;
constexpr size_t WS_RETCS = 1 * MiB;
constexpr size_t WS_DIFFCS = 2 * MiB;
constexpr size_t WS_XRC = 3 * MiB;
constexpr size_t WS_WGU = 19 * MiB;
constexpr size_t WS_WD = 30 * MiB;
constexpr size_t WS_H = 35 * MiB + 512 * 1024;
constexpr size_t WS_BIG = 107 * MiB + 512 * 1024;
constexpr size_t WS_WIN = WS_BIG;
constexpr size_t WS_WOUT0 = WS_BIG + 8 * MiB + 512 * 1024;
constexpr size_t WS_QKVR = 118 * MiB;
constexpr size_t WS_Z = 226 * MiB;
constexpr size_t WS_RQ = 262 * MiB, WS_RK = 298 * MiB, WS_RV = 334 * MiB, WS_RG = 370 * MiB;
constexpr size_t WS_AB = 406 * MiB;
constexpr size_t WS_O3 = 409 * MiB;
constexpr size_t WS_G = WS_BIG;
constexpr size_t WS_U = WS_BIG + 198 * MiB;
constexpr size_t WS_Q1 = WS_BIG, WS_K1 = WS_BIG + 72 * MiB, WS_VT = WS_BIG + 144 * MiB, WS_Y1 = WS_BIG + 216 * MiB;
constexpr size_t WS_WQK1 = 400 * MiB, WS_WV1 = 404 * MiB, WS_WO1 = 406 * MiB;
constexpr size_t WS_END = WS_U + 198 * MiB;
static_assert(WS_END <= 512 * MiB, "ws map");
constexpr int LDS_BYTES = 147456;

__device__ __forceinline__ unsigned cvtpk(float lo, float hi) { f32x2 v = {lo, hi}; bf16x2_t b = __builtin_convertvector(v, bf16x2_t); return __builtin_bit_cast(unsigned, b); }
__device__ __forceinline__ bf16_t f2bf(float f) { return (bf16_t)(cvtpk(f, 0.f) & 0xffffu); }
__device__ __forceinline__ float bf2f(unsigned short b) { return __uint_as_float(((unsigned)b) << 16); }
__device__ __forceinline__ float bflo(unsigned w) { return __uint_as_float(w << 16); }
__device__ __forceinline__ float bfhi(unsigned w) { return __uint_as_float(w & 0xffff0000u); }
__device__ __forceinline__ float silu_f(float x) { return x / (1.f + __expf(-x)); }
__device__ __forceinline__ float sigmoid_f(float x) { return 1.f / (1.f + __expf(-x)); }
__device__ __forceinline__ float wave_sum(float v) {
#pragma unroll
    for (int o = 1; o < 64; o <<= 1) v += __shfl_xor(v, o);
    return v;
}
__device__ __forceinline__ int crow(int r, int hi) { return (r & 3) + 8 * (r >> 2) + 4 * hi; }

namespace pg8 {
constexpr int BM = 256, BK = 64, HALF = 128, HTB = HALF * BK * 2, STAGE_BYTES = 8 * HTB, NXCD = 8, WGM = 8;
__host__ __device__ __forceinline__ int lds_byte(int r, int c) { const int st = (r >> 4) * 2 + (c >> 5), rr = r & 15, cc = c & 31, ob = rr * 64 + cc * 2; return st * 1024 + (ob ^ (((ob >> 9) & 1) << 5)); }
__host__ __device__ __forceinline__ void stage_rc(int b, int& R, int& C) { const int st = b / 1024, sb = b % 1024, swz = sb ^ (((sb >> 9) & 1) << 5); R = (st >> 1) * 16 + swz / 64; C = (st & 1) * 32 + (swz % 64) / 2; }
__host__ __device__ __forceinline__ int perm32(int rho) { const int n = rho >> 4, i = rho & 15; return 8 * (i >> 2) + 4 * n + (i & 3); }

struct Unit { int pm, pn, g; };
struct GemmDesc { const bf16_t* A; const bf16_t* Bt; int nM, nN; };

struct Order {
    const bf16_t *A0, *B0, *A1, *B1; int nM0, nN0, nM1, nN1; int K, G, c; int nwg0, nwg1;
    __device__ void init(int K_, int G_, int c_, GemmDesc g0) { K = K_; G = G_; c = c_; A0 = g0.A; B0 = g0.Bt; nM0 = g0.nM; nN0 = g0.nN; A1 = g0.A; B1 = g0.Bt; nM1 = 1; nN1 = 1; nwg0 = g0.nM * g0.nN; nwg1 = 0; }
    __device__ void init2(int K_, int G_, int c_, GemmDesc g0, GemmDesc g1) { K = K_; G = G_; c = c_; A0 = g0.A; B0 = g0.Bt; nM0 = g0.nM; nN0 = g0.nN; A1 = g1.A; B1 = g1.Bt; nM1 = g1.nM; nN1 = g1.nN; nwg0 = nM0 * nN0; nwg1 = nM1 * nN1; }
    __device__ bool next(int i, Unit& u) const {
        long L = (long)i * G + c; if (L >= nwg0 + nwg1) return false;
        int gi = 0, nwg = nwg0; if (L >= nwg0) { gi = 1; L -= nwg0; nwg = nwg1; }
        const int nM = gi ? nM1 : nM0, nN = gi ? nN1 : nN0;
        int wgid = (int)L; { const int q = nwg / NXCD, r = nwg % NXCD, xcd = wgid % NXCD, off = wgid / NXCD; wgid = (xcd < r ? xcd * (q + 1) : r * (q + 1) + (xcd - r) * q) + off; }
        const int nig = WGM * nN, gid = wgid / nig, fm = gid * WGM, gsz = (nM - fm) < WGM ? (nM - fm) : WGM;
        u.pm = fm + ((wgid % nig) % gsz); u.pn = (wgid % nig) / gsz; u.g = gi; return true;
    }
    __device__ __forceinline__ const char* abase(const Unit& u) const { return (const char*)(u.g ? A1 : A0) + (size_t)u.pm * (size_t)(BM * 2) * K; }
    __device__ __forceinline__ const char* bbase(const Unit& u) const { return (const char*)(u.g ? B1 : B0) + (size_t)u.pn * (size_t)(BM * 2) * K; }
};

template <class Epi, bool SP2 = true>
__device__ __forceinline__ void gemm_phase(LAS unsigned char* lds, const Order& S, const Epi& E) {
    const int tid = threadIdx.x, wid = __builtin_amdgcn_readfirstlane(tid >> 6), lane = tid & 63, wr = wid >> 2, wc = wid & 3, fr = lane & 15, fq = lane >> 4;
    const int K = S.K, nt = K / BK;
    unsigned voffA[2], voffB[2];
#pragma unroll
    for (int i = 0; i < 2; ++i) { int R, C; stage_rc(tid * 16 + i * 8192, R, C); const int Rb = Epi::PERM ? ((R & ~31) + perm32(R & 31)) : R;
        voffA[i] = (unsigned)(R * K + C) * 2u; voffB[i] = (unsigned)(Rb * K + C) * 2u; }
    const size_t kstep = (size_t)(BK * 2);
    const size_t hstep = (size_t)HALF * K * 2;
    const unsigned ldsw = (unsigned)wid * 1024u;
    const int aoff = lds_byte(wr * 64 + fr, fq * 8), boff = lds_byte(wc * 32 + fr, fq * 8);
#define PG8_SA(b, h) (((b) * 2 + (h)) * HTB)
#define PG8_SB(b, h) ((4 + (b) * 2 + (h)) * HTB)
#define PG8_STAGE(bufoff, gbase, voff) do { _Pragma("unroll") for (int _i = 0; _i < 2; ++_i) \
        __builtin_amdgcn_global_load_lds((const unsigned*)((const char*)(gbase) + (voff)[_i]), (LAS unsigned*)(lds + (bufoff) + ldsw + _i * 8192), 16, 0, 0); } while (0)
#define PG8_LDA(dst, b, h) do { _Pragma("unroll") for (int m = 0; m < 4; ++m) _Pragma("unroll") for (int k = 0; k < 2; ++k) dst[m][k] = *(const LAS bf16x8*)(lds + PG8_SA(b, h) + aoff + m * 2048 + k * 1024); } while (0)
#define PG8_LDB(dst, b, h) do { _Pragma("unroll") for (int n = 0; n < 2; ++n) _Pragma("unroll") for (int k = 0; k < 2; ++k) dst[n][k] = *(const LAS bf16x8*)(lds + PG8_SB(b, h) + boff + n * 2048 + k * 1024); } while (0)
#define PG8_MMA(ai, bj, At, Bt) do { __builtin_amdgcn_s_setprio(1); _Pragma("unroll") for (int m = 0; m < 4; ++m) _Pragma("unroll") for (int n = 0; n < 2; ++n) _Pragma("unroll") for (int k = 0; k < 2; ++k) \
        acc[ai][bj][m][n] = __builtin_amdgcn_mfma_f32_16x16x32_bf16(Bt[n][k], At[m][k], acc[ai][bj][m][n], 0, 0, 0); __builtin_amdgcn_s_setprio(0); } while (0)
#define PG8_WAIT_V(n) asm volatile("s_waitcnt vmcnt(" #n ")" ::: "memory")
#define PG8_WAIT_L(n) asm volatile("s_waitcnt lgkmcnt(" #n ")" ::: "memory")
#define PG8_BAR __builtin_amdgcn_s_barrier()
#define PG8_SCHED __builtin_amdgcn_sched_barrier(0)
    Unit cur, nxt; int ui = 0;
    if (!S.next(0, cur)) return;
    f32x4 acc[2][2][4][2];
#pragma unroll
    for (int a = 0; a < 2; ++a)
#pragma unroll
        for (int b = 0; b < 2; ++b)
#pragma unroll
            for (int m = 0; m < 4; ++m)
#pragma unroll
                for (int n = 0; n < 2; ++n) acc[a][b][m][n] = (f32x4){0.f, 0.f, 0.f, 0.f};
    bf16x8 At[4][2], B0[2][2], B1[2][2];
    const char* cA = S.abase(cur); const char* cB = S.bbase(cur);
    if constexpr (SP2) {
        PG8_STAGE(PG8_SB(0, 0), cB, voffB); PG8_STAGE(PG8_SB(0, 1), cB + hstep, voffB); PG8_STAGE(PG8_SA(0, 0), cA, voffA); PG8_STAGE(PG8_SA(0, 1), cA + hstep, voffA);
        if (wr == 1) PG8_BAR;
        PG8_WAIT_V(2); PG8_BAR;
        PG8_STAGE(PG8_SB(1, 0), cB + kstep, voffB); PG8_STAGE(PG8_SA(1, 0), cA + kstep, voffA); PG8_STAGE(PG8_SB(1, 1), cB + hstep + kstep, voffB);
        PG8_WAIT_V(6); PG8_BAR;
    } else {
        PG8_STAGE(PG8_SB(0, 0), cB, voffB); PG8_STAGE(PG8_SA(0, 0), cA, voffA); PG8_STAGE(PG8_SB(0, 1), cB + hstep, voffB); PG8_STAGE(PG8_SA(0, 1), cA + hstep, voffA);
        if (wr == 1) PG8_BAR;
        PG8_WAIT_V(4); PG8_BAR;
        PG8_STAGE(PG8_SB(1, 0), cB + kstep, voffB); PG8_STAGE(PG8_SA(1, 0), cA + kstep, voffA); PG8_STAGE(PG8_SB(1, 1), cB + hstep + kstep, voffB);
        PG8_WAIT_V(6); PG8_BAR;
    }
    for (;;) {
        const bool has_next = S.next(ui + 1, nxt);
        const char* nA = has_next ? S.abase(nxt) : cA; const char* nB = has_next ? S.bbase(nxt) : cB;
        for (int t = 0; t < nt; t += 2) {
            const bool last = (t == nt - 2);
            const char* a1 = cA + (size_t)(t + 1) * kstep;
            const char* a2 = last ? nA : cA + (size_t)(t + 2) * kstep; const char* b2 = last ? nB : cB + (size_t)(t + 2) * kstep;
            const char* a3 = a2 + kstep; const char* b3 = b2 + kstep;
            if constexpr (SP2) {
            PG8_LDB(B0, 0, 0); PG8_LDB(B1, 0, 1); PG8_SCHED; PG8_LDA(At, 0, 0); PG8_STAGE(PG8_SA(1, 1), a1 + hstep, voffA);
            PG8_WAIT_V(8); PG8_WAIT_L(0); PG8_BAR; PG8_MMA(0, 0, At, B0); PG8_MMA(0, 1, At, B1); PG8_BAR; PG8_SCHED;
            PG8_LDA(At, 0, 1); PG8_STAGE(PG8_SB(0, 0), b2, voffB); PG8_STAGE(PG8_SB(0, 1), b2 + hstep, voffB); PG8_STAGE(PG8_SA(0, 0), a2, voffA);
            PG8_WAIT_V(8); PG8_WAIT_L(0); PG8_BAR; PG8_MMA(1, 0, At, B0); PG8_MMA(1, 1, At, B1); PG8_BAR; PG8_SCHED;
            PG8_LDB(B0, 1, 0); PG8_LDB(B1, 1, 1); PG8_SCHED; PG8_LDA(At, 1, 0); PG8_STAGE(PG8_SA(0, 1), a2 + hstep, voffA);
            PG8_WAIT_V(8); PG8_WAIT_L(0); PG8_BAR; PG8_MMA(0, 0, At, B0); PG8_MMA(0, 1, At, B1); PG8_BAR; PG8_SCHED;
            PG8_LDA(At, 1, 1); PG8_STAGE(PG8_SB(1, 0), b3, voffB); PG8_STAGE(PG8_SB(1, 1), b3 + hstep, voffB); PG8_STAGE(PG8_SA(1, 0), a3, voffA);
            PG8_WAIT_V(8); PG8_WAIT_L(0); PG8_BAR; PG8_MMA(1, 0, At, B0); PG8_MMA(1, 1, At, B1); PG8_BAR; PG8_SCHED;
            } else {
            PG8_LDB(B0, 0, 0); PG8_SCHED; PG8_LDA(At, 0, 0); PG8_STAGE(PG8_SA(1, 1), a1 + hstep, voffA);
            PG8_WAIT_L(8); PG8_BAR; PG8_WAIT_L(0); PG8_MMA(0, 0, At, B0); PG8_BAR; PG8_SCHED;
            PG8_LDB(B1, 0, 1); PG8_STAGE(PG8_SB(0, 0), b2, voffB);
            PG8_BAR; PG8_WAIT_L(0); PG8_MMA(0, 1, At, B1); PG8_BAR;
            PG8_LDA(At, 0, 1); PG8_STAGE(PG8_SA(0, 0), a2, voffA);
            PG8_BAR; PG8_WAIT_L(0); PG8_MMA(1, 0, At, B0); PG8_BAR; PG8_SCHED;
            PG8_STAGE(PG8_SB(0, 1), b2 + hstep, voffB);
            PG8_WAIT_V(6); PG8_BAR; PG8_MMA(1, 1, At, B1); PG8_BAR;
            PG8_LDB(B0, 1, 0); PG8_SCHED; PG8_LDA(At, 1, 0); PG8_STAGE(PG8_SA(0, 1), a2 + hstep, voffA);
            PG8_WAIT_L(8); PG8_BAR; PG8_WAIT_L(0); PG8_MMA(0, 0, At, B0); PG8_BAR; PG8_SCHED;
            PG8_LDB(B1, 1, 1); PG8_STAGE(PG8_SB(1, 0), b3, voffB);
            PG8_BAR; PG8_WAIT_L(0); PG8_MMA(0, 1, At, B1); PG8_BAR;
            PG8_LDA(At, 1, 1); PG8_STAGE(PG8_SA(1, 0), a3, voffA);
            PG8_BAR; PG8_WAIT_L(0); PG8_MMA(1, 0, At, B0); PG8_BAR; PG8_SCHED;
            PG8_STAGE(PG8_SB(1, 1), b3 + hstep, voffB);
            PG8_WAIT_V(6); PG8_BAR; PG8_MMA(1, 1, At, B1); PG8_BAR;
            }
        }
        if (wr == 0) PG8_BAR;
        E(acc, cur, wr, wc, fr, fq);
        if (!has_next) break;
#pragma unroll
        for (int a = 0; a < 2; ++a)
#pragma unroll
            for (int b = 0; b < 2; ++b)
#pragma unroll
                for (int m = 0; m < 4; ++m)
#pragma unroll
                    for (int n = 0; n < 2; ++n) acc[a][b][m][n] = (f32x4){0.f, 0.f, 0.f, 0.f};
        cur = nxt; cA = nA; cB = nB; ++ui;
        if (wr == 1) PG8_BAR;
    }
    PG8_WAIT_V(0);
    PG8_BAR;
#undef PG8_SA
#undef PG8_SB
#undef PG8_STAGE
#undef PG8_LDA
#undef PG8_LDB
#undef PG8_MMA
#undef PG8_WAIT_V
#undef PG8_WAIT_L
#undef PG8_BAR
#undef PG8_SCHED
}
}
namespace epi {
using pg8::Unit; using pg8::BM; using pg8::HALF;
__device__ __forceinline__ void rot8(f32x4& v0, f32x4& v1, const f32x4 a, const f32x4 b) {
    float x, y;
    x = v0[0]; y = v0[1]; v0[0] = x * a[0] - y * a[1]; v0[1] = x * a[1] + y * a[0];
    x = v0[2]; y = v0[3]; v0[2] = x * a[2] - y * a[3]; v0[3] = x * a[3] + y * a[2];
    x = v1[0]; y = v1[1]; v1[0] = x * b[0] - y * b[1]; v1[1] = x * b[1] + y * b[0];
    x = v1[2]; y = v1[3]; v1[2] = x * b[2] - y * b[3]; v1[3] = x * b[3] + y * b[2];
}
__device__ __forceinline__ u32x4 pack8(const f32x4 v0, const f32x4 v1) { u32x4 w; w.x = cvtpk(v0[0], v0[1]); w.y = cvtpk(v0[2], v0[3]); w.z = cvtpk(v1[0], v1[1]); w.w = cvtpk(v1[2], v1[3]); return w; }

struct EpiIn {
    static constexpr bool PERM = true;
    bf16_t *QKVR, *Z, *RQ, *RK, *RV, *RG; const float* retcs;
    __device__ __forceinline__ void operator()(const f32x4 (&acc)[2][2][4][2], const Unit& u, int wr, int wc, int fr, int fq) const {
        bf16_t* base; int ldc, colt; bool rot = false; float sc = 1.f;
        if (u.pn < 6) { base = QKVR; ldc = 1536; colt = u.pn * 256; }
        else { const int t = (u.pn - 6) >> 1; colt = ((u.pn - 6) & 1) * 256; ldc = 512; base = t == 0 ? Z : t == 1 ? RQ : t == 2 ? RK : t == 3 ? RV : RG;
               rot = (t == 1 || t == 2) && (u.pm < ML / 256); if (t == 2) sc = 0.088388347648318447f; }
        const int row0 = u.pm * BM + wr * 64 + fr, col0 = colt + wc * 32 + 8 * fq;
#pragma unroll
        for (int ai = 0; ai < 2; ++ai)
#pragma unroll
            for (int m = 0; m < 4; ++m) { const int row = row0 + ai * HALF + m * 16; const int pos = row & (SEQL - 1);
#pragma unroll
                for (int bj = 0; bj < 2; ++bj) { f32x4 v0 = acc[ai][bj][m][0], v1 = acc[ai][bj][m][1]; const int c = col0 + bj * HALF;
                    if (rot) { const f32x4* cs = (const f32x4*)(retcs + ((size_t)pos * 64 + ((c & 127) >> 1)) * 2); rot8(v0, v1, cs[0], cs[1]); }
                    v0 = v0 * sc; v1 = v1 * sc;
                    *(u32x4*)(base + (size_t)row * ldc + c) = pack8(v0, v1); } }
    }
};
struct EpiQKV1 {
    static constexpr bool PERM = true;
    bf16_t *Q1, *K1, *VT; const float* diffcs;
    __device__ __forceinline__ void operator()(const f32x4 (&acc)[2][2][4][2], const Unit& u, int wr, int wc, int fr, int fq) const {
        if (u.g == 1) {
            const int row0 = u.pm * BM + wr * 64 + fr, col0 = u.pn * BM + wc * 32 + 8 * fq;
#pragma unroll
            for (int ai = 0; ai < 2; ++ai)
#pragma unroll
                for (int m = 0; m < 4; ++m) { const int row = row0 + ai * HALF + m * 16;
#pragma unroll
                    for (int bj = 0; bj < 2; ++bj) *(u32x4*)(VT + (size_t)row * MT + col0 + bj * HALF) = pack8(acc[ai][bj][m][0], acc[ai][bj][m][1]); }
            return;
        }
        bf16_t* base = (u.pn < 4) ? Q1 : K1; const int colt = (u.pn & 3) * 256; const float sc = (u.pn < 4) ? ATT_C2 : 1.f; const bool rot = u.pm < ML / 256;
        const int row0 = u.pm * BM + wr * 64 + fr, col0 = colt + wc * 32 + 8 * fq;
#pragma unroll
        for (int ai = 0; ai < 2; ++ai)
#pragma unroll
            for (int m = 0; m < 4; ++m) { const int row = row0 + ai * HALF + m * 16; const int pos = row & (SEQL - 1);
#pragma unroll
                for (int bj = 0; bj < 2; ++bj) { f32x4 v0 = acc[ai][bj][m][0], v1 = acc[ai][bj][m][1]; const int c = col0 + bj * HALF;
                    if (rot) { const f32x4* cs = (const f32x4*)(diffcs + ((size_t)pos * 32 + ((c & 63) >> 1)) * 2); rot8(v0, v1, cs[0], cs[1]); }
                    v0 = v0 * sc; v1 = v1 * sc;
                    *(u32x4*)(base + (size_t)row * 1024 + c) = pack8(v0, v1); } }
    }
};
struct EpiGU {
    static constexpr bool PERM = true;
    bf16_t *G, *U;
    __device__ __forceinline__ void operator()(const f32x4 (&acc)[2][2][4][2], const Unit& u, int wr, int wc, int fr, int fq) const {
        bf16_t* base = (u.pn < 11) ? G : U; const int colt = (u.pn < 11 ? u.pn : u.pn - 11) * 256;
        const int row0 = u.pm * BM + wr * 64 + fr, col0 = colt + wc * 32 + 8 * fq;
#pragma unroll
        for (int ai = 0; ai < 2; ++ai)
#pragma unroll
            for (int m = 0; m < 4; ++m) { const int row = row0 + ai * HALF + m * 16;
#pragma unroll
                for (int bj = 0; bj < 2; ++bj) *(u32x4*)(base + (size_t)row * DFF + col0 + bj * HALF) = pack8(acc[ai][bj][m][0], acc[ai][bj][m][1]); }
    }
};
struct EpiRes {
    static constexpr bool PERM = false;
    const float *xinL, *xinC; float *outL, *outC; const float* gate;
    __device__ __forceinline__ void operator()(const f32x4 (&acc)[2][2][4][2], const Unit& u, int wr, int wc, int fr, int fq) const {
        const bool lat = u.pm < ML / 256; const int mr = lat ? (u.pm >> 3) : 16;
        const float* xin = lat ? xinL : xinC - (size_t)ML * D; float* out = lat ? outL : outC - (size_t)ML * D;
        const float* gp = gate + (size_t)mr * 6144;
        const int col0 = u.pn * BM + wc * 32 + 4 * fq;
#pragma unroll
        for (int bj = 0; bj < 2; ++bj)
#pragma unroll
            for (int n = 0; n < 2; ++n) { const int c = col0 + bj * HALF + n * 16; const f32x4 gv = *(const f32x4*)(gp + c);
#pragma unroll
                for (int ai = 0; ai < 2; ++ai)
#pragma unroll
                    for (int m = 0; m < 4; ++m) { const size_t off = (size_t)(u.pm * BM + ai * HALF + wr * 64 + m * 16 + fr) * D + c;
                        const f32x4 xv = *(const f32x4*)(xin + off); *(f32x4*)(out + off) = xv * DEEP_ALPHA + gv * acc[ai][bj][m][n]; } }
    }
};
}
struct Args {
    const float* in[23];
    float* out; unsigned char* ws;
};
struct Ctx {
    LAS unsigned char* lds; int tid, lane, wave, G, vcu, bid;
    const Args* a;
};
#define IN_X 0
#define IN_C 1
#define IN_CTX 2
#define IN_CCTX 3
#define IN_MODW 4
#define IN_MODB 5
#define IN_LNG 6
#define IN_LNB 7
#define IN_EWIN 8
#define IN_ECONV 9
#define IN_EALOG 10
#define IN_EDTB 11
#define IN_ENORMW 12
#define IN_ERETD 13
#define IN_EWOUT 14
#define IN_OWQKV 15
#define IN_OLAM 16
#define IN_OSUBLN 17
#define IN_OWOUT 18
#define IN_FWG 19
#define IN_FWU 20
#define IN_FCONV 21
#define IN_FWD 22

template <class Map>
__device__ __forceinline__ void transpose_item(const float* W, int ldw, int K, bf16_t* WT, LAS float* scr, int item, int nblk, int lane, Map map) {
    const int kb = item / nblk, nb = item % nblk, k0 = 64 * kb, n0 = 32 * nb;
    const int sc = map(n0 + (lane & 31));
#pragma unroll 8
    for (int i = 0; i < 32; ++i) { const int kk = 2 * i + (lane >> 5); scr[kk * 33 + (lane & 31)] = sc >= 0 ? W[(size_t)(k0 + kk) * ldw + sc] : 0.f; }
    asm volatile("s_waitcnt lgkmcnt(0)" ::: "memory");
    const int c = lane & 7;
#pragma unroll
    for (int j = 0; j < 4; ++j) { const int n = (lane >> 3) + 8 * j; const LAS float* s = scr + (8 * c) * 33 + n;
        u32x4 o; o.x = cvtpk(s[0 * 33], s[1 * 33]); o.y = cvtpk(s[2 * 33], s[3 * 33]); o.z = cvtpk(s[4 * 33], s[5 * 33]); o.w = cvtpk(s[6 * 33], s[7 * 33]);
        *(u32x4*)(WT + (size_t)(n0 + n) * K + k0 + 8 * c) = o; }
    asm volatile("s_waitcnt lgkmcnt(0)" ::: "memory");
}
struct MapId { int off; __device__ int operator()(int n) const { return n + off; } };
struct MapWin {
    __device__ int operator()(int n) const {
        if (n < 2048) return n;
        if (n < 3072) { const int t = (n - 2048) >> 9, e = (n - 2048) & 511, hh = e >> 7, w = e & 127, p = w >> 1, s = w & 1; return (t == 0 ? 2064 : 2576) + hh * 128 + p + 64 * s; }
        if (n < 3584) return 3088 + (n - 3072);
        return 3600 + (n - 3584);
    }
};
struct MapQK1 {
    __device__ int operator()(int n) const { const int blk = n >> 6, e = n & 63, p = e >> 1, s = e & 1; return blk * 64 + p + 32 * s; }
};
struct MapGU { __device__ int operator()(int n) const { return n; } };

__device__ __forceinline__ void p0_weights_l0(const Ctx& C) {
    LAS float* scr = (LAS float*)(C.lds + C.wave * 16384);
    const int gw = C.vcu * NWAVES + C.wave, NGW = C.G * NWAVES;
    const Args& A = *C.a; unsigned char* ws = A.ws;
    constexpr int I_IN = 16 * 128, I_OUT = 16 * 32, I_G = 16 * 88, I_D = 44 * 32;
    for (int it = gw; it < I_IN + I_OUT + 2 * I_G + I_D; it += NGW) {
        int r = it;
        if (r < I_IN) { transpose_item(A.in[IN_EWIN], 4112, 1024, (bf16_t*)(ws + WS_WIN), scr, r, 128, C.lane, MapWin{}); continue; } r -= I_IN;
        if (r < I_OUT) { transpose_item(A.in[IN_EWOUT], 1024, 1024, (bf16_t*)(ws + WS_WOUT0), scr, r, 32, C.lane, MapId{0}); continue; } r -= I_OUT;
        if (r < I_G) { transpose_item(A.in[IN_FWG], DFF, 1024, (bf16_t*)(ws + WS_WGU), scr, r, 88, C.lane, MapId{0}); continue; } r -= I_G;
        if (r < I_G) { transpose_item(A.in[IN_FWU], DFF, 1024, (bf16_t*)(ws + WS_WGU) + (size_t)DFF * 1024, scr, r, 88, C.lane, MapId{0}); continue; } r -= I_G;
        transpose_item(A.in[IN_FWD], 1024, DFF, (bf16_t*)(ws + WS_WD), scr, r, 32, C.lane, MapId{0});
    }
}
__device__ __forceinline__ void p_weights_l1(const Ctx& C) {
    LAS float* scr = (LAS float*)(C.lds + C.wave * 16384);
    const int gw = C.vcu * NWAVES + C.wave, NGW = C.G * NWAVES;
    const Args& A = *C.a; unsigned char* ws = A.ws;
    constexpr int I_QK = 16 * 64, I_V = 16 * 32, I_O = 16 * 32, I_G = 16 * 88, I_D = 44 * 32;
    const float* fg = A.in[IN_FWG] + (size_t)1024 * DFF; const float* fu = A.in[IN_FWU] + (size_t)1024 * DFF; const float* fd = A.in[IN_FWD] + (size_t)DFF * 1024;
    for (int it = gw; it < I_QK + I_V + I_O + 2 * I_G + I_D; it += NGW) {
        int r = it;
        if (r < I_QK) { transpose_item(A.in[IN_OWQKV], 3072, 1024, (bf16_t*)(ws + WS_WQK1), scr, r, 64, C.lane, MapQK1{}); continue; } r -= I_QK;
        if (r < I_V) { transpose_item(A.in[IN_OWQKV], 3072, 1024, (bf16_t*)(ws + WS_WV1), scr, r, 32, C.lane, MapId{2048}); continue; } r -= I_V;
        if (r < I_O) { transpose_item(A.in[IN_OWOUT], 1024, 1024, (bf16_t*)(ws + WS_WO1), scr, r, 32, C.lane, MapId{0}); continue; } r -= I_O;
        if (r < I_G) { transpose_item(fg, DFF, 1024, (bf16_t*)(ws + WS_WGU), scr, r, 88, C.lane, MapId{0}); continue; } r -= I_G;
        if (r < I_G) { transpose_item(fu, DFF, 1024, (bf16_t*)(ws + WS_WGU) + (size_t)DFF * 1024, scr, r, 88, C.lane, MapId{0}); continue; } r -= I_G;
        transpose_item(fd, 1024, DFF, (bf16_t*)(ws + WS_WD), scr, r, 32, C.lane, MapId{0});
    }
}
__device__ __forceinline__ void p0_mod(const Ctx& C) {
    const Args& A = *C.a; float* MOD = (float*)(A.ws + WS_MOD);
    LAS float* act = (LAS float*)(C.lds + 65536) + C.wave * (17 * 128);
    LAS float* red = (LAS float*)(C.lds);
    for (int task = C.bid; task < 2 * 96; task += C.G) {
        const int l = task / 96, cg_ = task % 96, col = cg_ * 64 + C.lane, k0 = C.wave * 128;
        for (int e = C.lane; e < 17 * 128; e += 64) { const int r = e >> 7, k = e & 127; const float v = r < 16 ? A.in[IN_C][r * 1024 + k0 + k] : A.in[IN_CCTX][k0 + k]; act[e] = silu_f(v); }
        asm volatile("s_waitcnt lgkmcnt(0)" ::: "memory");
        float acc[17];
#pragma unroll
        for (int r = 0; r < 17; ++r) acc[r] = 0.f;
        const float* wp = A.in[IN_MODW] + ((size_t)l * 1024 + k0) * 6144 + col;
#pragma unroll 4
        for (int k = 0; k < 128; ++k) { const float w = wp[(size_t)k * 6144];
#pragma unroll
            for (int r = 0; r < 17; ++r) acc[r] += act[r * 128 + k] * w; }
#pragma unroll
        for (int r = 0; r < 17; ++r) red[(C.wave * 17 + r) * 64 + C.lane] = acc[r];
        __syncthreads();
        for (int e = C.tid; e < 17 * 64; e += NTHREADS) { const int r = e >> 6, cc = e & 63; float s = 0.f;
#pragma unroll
            for (int w = 0; w < 8; ++w) s += red[(w * 17 + r) * 64 + cc];
            MOD[((size_t)l * 17 + r) * 6144 + cg_ * 64 + cc] = s + A.in[IN_MODB][l * 6144 + cg_ * 64 + cc]; }
        __syncthreads();
    }
}
__device__ __forceinline__ void sincos_rev(float ang, float& c, float& s) {
    const double rev = (double)ang * 0.15915494309189533577; const float fr = (float)(rev - floor(rev));
    s = __builtin_amdgcn_sinf(fr); c = __builtin_amdgcn_cosf(fr);
}
__device__ __forceinline__ void p0_tables(const Ctx& C) {
    const Args& A = *C.a; float* rcs = (float*)(A.ws + WS_RETCS); float* dcs = (float*)(A.ws + WS_DIFFCS);
    const int gt = C.bid * NTHREADS + C.tid, NT = C.G * NTHREADS;
    for (int e = gt; e < 2048 * 64; e += NT) { const int pos = e >> 6, p = e & 63; const float inv = exp2f(-(float)p * (13.287712379549449f / 64.f)); float c, s; sincos_rev((float)pos * inv, c, s); rcs[2 * e] = c; rcs[2 * e + 1] = s; }
    for (int e = gt; e < 2048 * 32; e += NT) { const int pos = e >> 5, p = e & 31; const float inv = exp2f(-(float)(p & 15) * (13.287712379549449f / 16.f));
        const float pp = (float)(p < 16 ? (pos >> 6) : (pos & 63)); float c, s; sincos_rev(pp * inv, c, s); dcs[2 * e] = c; dcs[2 * e + 1] = s; }
    if (gt == 0) { const float* lp = A.in[IN_OLAM]; float s01 = 0.f, s23 = 0.f; for (int i = 0; i < 64; ++i) { s01 += lp[i] * lp[64 + i]; s23 += lp[128 + i] * lp[192 + i]; }
        ((float*)(A.ws + WS_CTL))[0] = __expf(s01) - __expf(s23) + LAMBDA_INIT1; }
}

__device__ __forceinline__ void p1_modulate_ab(const Ctx& C) {
    const Args& A = *C.a; const float* MOD = (const float*)(A.ws + WS_MOD); bf16_t* H = (bf16_t*)(A.ws + WS_H); float* AB = (float*)(A.ws + WS_AB);
    LAS float* wab = (LAS float*)C.lds;
    for (int e = C.tid; e < 16 * 1024; e += NTHREADS) { const int k = e >> 4, j = e & 15; wab[j * 1024 + k] = A.in[IN_EWIN][(size_t)k * 4112 + 2048 + j]; }
    __syncthreads();
    const int gw = C.vcu * NWAVES + C.wave, NGW = C.G * NWAVES;
    for (int row = gw; row < MT; row += NGW) {
        const bool lat = row < ML; const float* xr = lat ? A.in[IN_X] + (size_t)row * D : A.in[IN_CTX] + (size_t)(row - ML) * D;
        const float* mp = MOD + (size_t)(lat ? (row >> 11) : 16) * 6144;
        f32x4 hv[4];
#pragma unroll
        for (int j = 0; j < 4; ++j) { const int c = 4 * C.lane + 256 * j; const f32x4 xv = *(const f32x4*)(xr + c), sh = *(const f32x4*)(mp + c), sc = *(const f32x4*)(mp + 1024 + c);
            hv[j] = xv * (sc + 1.f) + sh; u32x2 w; w.x = cvtpk(hv[j][0], hv[j][1]); w.y = cvtpk(hv[j][2], hv[j][3]); *(u32x2*)(H + (size_t)row * D + c) = w; }
        float mine = 0.f;
#pragma unroll 2
        for (int q = 0; q < 16; ++q) { float s = 0.f;
#pragma unroll
            for (int j = 0; j < 4; ++j) { const f32x4 w = *(const LAS f32x4*)(wab + q * 1024 + 4 * C.lane + 256 * j); s += hv[j][0] * w[0] + hv[j][1] * w[1] + hv[j][2] * w[2] + hv[j][3] * w[3]; }
            s = wave_sum(s); mine = (C.lane == q) ? s : mine; }
        if (C.lane < 16) AB[(size_t)row * 16 + C.lane] = mine;
    }
    __syncthreads();
}
__device__ __forceinline__ void p_ln(const Ctx& C, int nrows, const float* lng, const float* lnb, const float* modbase  , int shoff, int scoff, bool want_h) {
    const Args& A = *C.a; bf16_t* H = (bf16_t*)(A.ws + WS_H);
    const int gw = C.vcu * NWAVES + C.wave, NGW = C.G * NWAVES;
    f32x4 gv[4], bv[4];
#pragma unroll
    for (int j = 0; j < 4; ++j) { const int c = 4 * C.lane + 256 * j; gv[j] = *(const f32x4*)(lng + c); bv[j] = *(const f32x4*)(lnb + c); }
    for (int row = gw; row < nrows; row += NGW) {
        const bool lat = row < ML; float* xr = lat ? A.out + (size_t)row * D : (float*)(A.ws + WS_XRC) + (size_t)(row - ML) * D;
        f32x4 v[4]; float s = 0.f;
#pragma unroll
        for (int j = 0; j < 4; ++j) { v[j] = *(const f32x4*)(xr + 4 * C.lane + 256 * j); s += (v[j][0] + v[j][1]) + (v[j][2] + v[j][3]); }
        const float mean = wave_sum(s) * (1.f / D); float s2 = 0.f;
#pragma unroll
        for (int j = 0; j < 4; ++j) { v[j] = v[j] - mean; s2 += (v[j][0] * v[j][0] + v[j][1] * v[j][1]) + (v[j][2] * v[j][2] + v[j][3] * v[j][3]); }
        const float rstd = rsqrtf(wave_sum(s2) * (1.f / D) + LN_EPS);
        const float* mp = modbase ? modbase + (size_t)(lat ? (row >> 11) : 16) * 6144 : nullptr;
#pragma unroll
        for (int j = 0; j < 4; ++j) { const int c = 4 * C.lane + 256 * j; const f32x4 y = v[j] * rstd * gv[j] + bv[j]; *(f32x4*)(xr + c) = y;
            if (want_h) { const f32x4 sh = *(const f32x4*)(mp + shoff + c), sc = *(const f32x4*)(mp + scoff + c); const f32x4 h = y * (sc + 1.f) + sh;
                u32x2 w; w.x = cvtpk(h[0], h[1]); w.y = cvtpk(h[2], h[3]); *(u32x2*)(H + (size_t)row * D + c) = w; } }
    }
}
__device__ __forceinline__ void p5_finish(const Ctx& C) {
    const Args& A = *C.a; bf16_t* Y = (bf16_t*)(A.ws + WS_H);
    const bf16_t* O0 = (const bf16_t*)A.out; const bf16_t* O1 = O0 + (size_t)MT * 512; const bf16_t* O2 = O1 + (size_t)MT * 512; const bf16_t* O3 = (const bf16_t*)(A.ws + WS_O3);
    const bf16_t* Z = (const bf16_t*)(A.ws + WS_Z); const bf16_t* RG = (const bf16_t*)(A.ws + WS_RG);
    const int gw = C.vcu * NWAVES + C.wave, NGW = C.G * NWAVES;
    const int kind = C.lane >> 5, c0 = (C.lane & 31) * 16;
    float nw[16];
#pragma unroll
    for (int e = 0; e < 16; ++e) nw[e] = A.in[IN_ENORMW][(c0 & 127) + e];
    for (int row = gw; row < MT; row += NGW) {
        const bf16_t* pa = (kind ? O2 : O0) + (size_t)row * 512 + c0; const bf16_t* pb = (kind ? O3 : O1) + (size_t)row * 512 + c0; const bf16_t* pg = (kind ? RG : Z) + (size_t)row * 512 + c0;
        float o[16], gt[16];
#pragma unroll
        for (int q = 0; q < 2; ++q) { const u32x4 a = *(const u32x4*)(pa + 8 * q), b = *(const u32x4*)(pb + 8 * q), g = *(const u32x4*)(pg + 8 * q);
#pragma unroll
            for (int e = 0; e < 4; ++e) { o[8 * q + 2 * e] = bflo(a[e]) + bflo(b[e]); o[8 * q + 2 * e + 1] = bfhi(a[e]) + bfhi(b[e]); gt[8 * q + 2 * e] = bflo(g[e]); gt[8 * q + 2 * e + 1] = bfhi(g[e]); } }
        float s = 0.f, ss = 0.f;
#pragma unroll
        for (int e = 0; e < 16; ++e) { s += o[e]; }
        s += __shfl_xor(s, 1); s += __shfl_xor(s, 2); s += __shfl_xor(s, 4);
        const float mu = kind ? s * (1.f / 128.f) : 0.f;
#pragma unroll
        for (int e = 0; e < 16; ++e) { o[e] -= mu; ss += o[e] * o[e]; }
        ss += __shfl_xor(ss, 1); ss += __shfl_xor(ss, 2); ss += __shfl_xor(ss, 4);
        const float rn = rsqrtf(ss * (1.f / 128.f) + NORM_EPS);
        u32x4 w[2];
#pragma unroll
        for (int q = 0; q < 2; ++q)
#pragma unroll
            for (int e = 0; e < 4; ++e) { const int i0 = 8 * q + 2 * e; const float y0 = o[i0] * rn * (kind ? 1.f : nw[i0]) * silu_f(gt[i0]), y1 = o[i0 + 1] * rn * (kind ? 1.f : nw[i0 + 1]) * silu_f(gt[i0 + 1]); w[q][e] = cvtpk(y0, y1); }
        bf16_t* yp = Y + (size_t)row * D + kind * 512 + c0;
        *(u32x4*)(yp) = w[0]; *(u32x4*)(yp + 8) = w[1];
    }
}
__device__ __forceinline__ f32x4 ld4bf(const bf16_t* p) { const u32x2 w = *(const u32x2*)p; return (f32x4){bflo(w.x), bfhi(w.x), bflo(w.y), bfhi(w.y)}; }
__device__ __forceinline__ void p_conv(const Ctx& C, int li, bool with_ctx) {
    const Args& A = *C.a; const bf16_t* G = (const bf16_t*)(A.ws + WS_G); bf16_t* U = (bf16_t*)(A.ws + WS_U);
    const float* cw = A.in[IN_FCONV] + (size_t)li * 9 * DFF;
    const int gw = C.vcu * NWAVES + C.wave, NGW = C.G * NWAVES;
    const int ntask = (NB * 32 + (with_ctx ? NB * 4 : 0)) * 11;
    for (int task = gw; task < ntask; task += NGW) {
        const int cb = task % 11, st = task / 11; const int ch0 = cb * 256 + C.lane * 4;
        int tok0, W, c_start; bool up, dn;
        if (st < NB * 32) { const int b = st >> 5, rr = st & 31; tok0 = b * SEQL + rr * 64; W = 64; c_start = 0; up = rr > 0; dn = rr < 31; }
        else { const int s2 = st - NB * 32, b = s2 >> 2, sg = s2 & 3; tok0 = ML + b * CTXL + sg * 64; W = 256; c_start = sg * 64; up = false; dn = false; }
        f32x4 w[9];
#pragma unroll
        for (int q = 0; q < 9; ++q) w[q] = *(const f32x4*)(cw + q * DFF + ch0);
        const f32x4 zero = {0.f, 0.f, 0.f, 0.f};
        const bf16_t* gp = G + (size_t)tok0 * DFF + ch0;
        f32x4 P[3], Cc[3], N[3];
#define LDCOL(dst, cc) do { const int c_ = (cc); const bool ok_ = (c_start + c_) >= 0 && (c_start + c_) < W; const bf16_t* q_ = gp + (ptrdiff_t)c_ * DFF; \
        dst[0] = (ok_ && up) ? ld4bf(q_ - (ptrdiff_t)64 * DFF) : zero; dst[1] = ok_ ? ld4bf(q_) : zero; dst[2] = (ok_ && dn) ? ld4bf(q_ + (ptrdiff_t)64 * DFF) : zero; } while (0)
        LDCOL(P, -1); LDCOL(Cc, 0); LDCOL(N, 1);
        for (int cc = 0; cc < 64; ++cc) {
            f32x4 NN[3]; LDCOL(NN, cc + 2);
            bf16_t* up_ = U + (size_t)(tok0 + cc) * DFF + ch0; const f32x4 uv = ld4bf(up_);
            f32x4 a = zero;
#pragma unroll
            for (int di = 0; di < 3; ++di) a += w[di * 3 + 0] * P[di] + w[di * 3 + 1] * Cc[di] + w[di * 3 + 2] * N[di];
            u32x2 o; o.x = cvtpk(silu_f(a[0]) * uv[0], silu_f(a[1]) * uv[1]); o.y = cvtpk(silu_f(a[2]) * uv[2], silu_f(a[3]) * uv[3]); *(u32x2*)up_ = o;
#pragma unroll
            for (int di = 0; di < 3; ++di) { P[di] = Cc[di]; Cc[di] = N[di]; N[di] = NN[di]; }
        }
#undef LDCOL
    }
}
namespace conv {
constexpr int ROWB = 66 * 128, TILE = 6 * ROWB;
static_assert(2 * TILE <= LDS_BYTES, "conv LDS");
__device__ __forceinline__ void glds16(const void* gsrc, unsigned lds_dst) { unsigned keep;
    asm volatile("s_mov_b32 %0, m0\n\ts_mov_b32 m0, %2\n\ts_nop 0\n\tglobal_load_lds_dwordx4 %1, off\n\ts_mov_b32 m0, %0" : "=&s"(keep) : "v"(gsrc), "s"(lds_dst) : "memory"); }
__device__ __forceinline__ void unpack8(const u32x4 a, float (&f)[8]) {
#pragma unroll
    for (int e = 0; e < 4; ++e) { f[2 * e] = bflo(a[e]); f[2 * e + 1] = bfhi(a[e]); }
}
__device__ __forceinline__ void p_conv2(const Ctx& C, int li, bool with_ctx) {
    const Args& A = *C.a; const bf16_t* G = (const bf16_t*)(A.ws + WS_G); bf16_t* U = (bf16_t*)(A.ws + WS_U);
    const float* cw = A.in[IN_FCONV] + (size_t)li * 9 * DFF;
    const int tid = C.tid, lane = C.lane, wid = C.wave, c8 = tid & 7, col = tid >> 3;
    const int ntl = NB * 8 * 44, ntask = ntl + (with_ctx ? NB * 44 : 0);
    LAS unsigned char* lds = C.lds;
    for (int e = tid; e < 2 * 6 * 2 * 8; e += NTHREADS) { const int bufi = e / 96, rem = e % 96, j = rem / 16, side = (rem >> 3) & 1, ch = rem & 7;
        *(LAS u32x4*)(lds + bufi * TILE + j * ROWB + (side ? 65 : 0) * 128 + ch * 16) = (u32x4){0u, 0u, 0u, 0u}; }
    u32x4 un[4];
    auto issue = [&](int task, int bufi) {
        LAS unsigned char* buf = lds + bufi * TILE;
        if (task < ntl) {
            const int cb = task % 44, t2 = task / 44, rg = t2 & 7, b = t2 >> 3; const int ch0 = cb * 64;
#pragma unroll
            for (int k = 0; k < 6; ++k) { const int q = wid * 6 + k, j = q >> 3, i = q & 7; const int grow = rg * 4 - 1 + j;
                if (grow >= 0 && grow < 32) {
                    const int token = b * SEQL + grow * 64 + 8 * i + (lane >> 3);
                    glds16(G + (size_t)token * DFF + ch0 + (lane & 7) * 8, (unsigned)__builtin_amdgcn_readfirstlane((int)(unsigned)(size_t)(buf + j * ROWB + (1 + 8 * i) * 128)));
                } }
            if (rg == 0) { for (int e = tid; e < 528; e += NTHREADS) *(LAS u32x4*)(buf + e * 16) = (u32x4){0u, 0u, 0u, 0u}; }
            if (rg == 7) { for (int e = tid; e < 528; e += NTHREADS) *(LAS u32x4*)(buf + 5 * ROWB + e * 16) = (u32x4){0u, 0u, 0u, 0u}; }
#pragma unroll
            for (int rr = 0; rr < 4; ++rr) { const int token = b * SEQL + (rg * 4 + rr) * 64 + col; un[rr] = *(const u32x4*)(U + (size_t)token * DFF + ch0 + c8 * 8); }
        } else {
            const int t2 = task - ntl, cb = t2 % 44, b = t2 / 44; const int ch0 = cb * 64;
#pragma unroll
            for (int k = 0; k < 4; ++k) { const int q = wid * 4 + k; const int token = ML + b * CTXL + 8 * q + (lane >> 3);
                glds16(G + (size_t)token * DFF + ch0 + (lane & 7) * 8, (unsigned)__builtin_amdgcn_readfirstlane((int)(unsigned)(size_t)(buf + (8 * q) * 128))); }
#pragma unroll
            for (int rr = 0; rr < 4; ++rr) { const int token = ML + b * CTXL + rr * 64 + col; un[rr] = *(const u32x4*)(U + (size_t)token * DFF + ch0 + c8 * 8); }
        }
    };
    int task = C.bid, bufi = 0;
    if (task < ntask) issue(task, 0);
    for (; task < ntask; task += C.G, bufi ^= 1) {
        asm volatile("s_waitcnt vmcnt(0)" ::: "memory");
        __syncthreads();
        u32x4 uc[4];
#pragma unroll
        for (int rr = 0; rr < 4; ++rr) uc[rr] = un[rr];
        const LAS unsigned char* buf = lds + bufi * TILE;
        const bool lat = task < ntl; const int cb = lat ? task % 44 : (task - ntl) % 44; const int ch0 = cb * 64;
        f32x4 w[9][2];
#pragma unroll
        for (int q = 0; q < 9; ++q) { w[q][0] = *(const f32x4*)(cw + q * DFF + ch0 + c8 * 8); w[q][1] = *(const f32x4*)(cw + q * DFF + ch0 + c8 * 8 + 4); }
#pragma unroll
        for (int q = 0; q < 9; ++q) asm volatile("" : "+v"(w[q][0]), "+v"(w[q][1]));
#pragma unroll
        for (int rr = 0; rr < 4; ++rr) asm volatile("" : "+v"(uc[rr]));
        __builtin_amdgcn_sched_barrier(0);
        if (task + C.G < ntask) issue(task + C.G, bufi ^ 1);
        __builtin_amdgcn_sched_barrier(0);
        size_t tok0;
        if (lat) { const int t2 = task / 44, rg = t2 & 7, b = t2 >> 3; tok0 = (size_t)b * SEQL + rg * 256; } else { const int b = (task - ntl) / 44; tok0 = (size_t)ML + b * CTXL; }
#pragma unroll
        for (int rr = 0; rr < 4; ++rr) {
            float acc[8];
#pragma unroll
            for (int e = 0; e < 8; ++e) acc[e] = 0.f;
            if (lat) {
#pragma unroll
                for (int di = 0; di < 3; ++di)
#pragma unroll
                    for (int dj = 0; dj < 3; ++dj) { float x[8]; unpack8(*(const LAS u32x4*)(buf + (rr + di) * ROWB + (col + dj) * 128 + c8 * 16), x);
#pragma unroll
                        for (int e = 0; e < 8; ++e) acc[e] += x[e] * w[di * 3 + dj][e >> 2][e & 3]; }
            } else {
                const int t = rr * 64 + col;
#pragma unroll
                for (int dj = 0; dj < 3; ++dj) { const int tt = t + dj - 1; float x[8]; const u32x4 raw = *(const LAS u32x4*)(buf + (tt < 0 ? 0 : tt > 255 ? 255 : tt) * 128 + c8 * 16); unpack8(raw, x);
                    const float ok = (tt >= 0 && tt < 256) ? 1.f : 0.f;
#pragma unroll
                    for (int e = 0; e < 8; ++e) acc[e] += x[e] * ok * w[3 + dj][e >> 2][e & 3]; }
            }
            float uv[8]; unpack8(uc[rr], uv);
            u32x4 o;
#pragma unroll
            for (int e = 0; e < 4; ++e) o[e] = cvtpk(silu_f(acc[2 * e]) * uv[2 * e], silu_f(acc[2 * e + 1]) * uv[2 * e + 1]);
            *(u32x4*)(U + (tok0 + rr * 64 + col) * DFF + ch0 + c8 * 8) = o;
        }
    }
    asm volatile("s_waitcnt vmcnt(0)" ::: "memory");
    __syncthreads();
}
}
namespace scan {
constexpr int LDK = 136, LDC = 72;
constexpr size_t WS_QP = WS_H, WS_KP = WS_H + 36 * MiB, WS_VP = 445 * MiB, WS_GCUM = 481 * MiB, WS_BETA = 483 * MiB;
constexpr int S_ST = 0, S_KI = 34816, S_Q = 51200, S_ACOL = 68608, S_QKM = 84992, S_TM = 94208, S_KBG = 103424, S_VB = 121856, S_GS = 140288, S_BS = 140544, S_EG = 140800, S_EK = 141056;
constexpr int R_KI = 34816, R_Q = 51200, R_VI = 68608, R_VS = 84992, R_PM = 101376;
static_assert(S_EK + 256 <= LDS_BYTES && R_PM + 9216 <= LDS_BYTES, "scan LDS map");
#define MFMA32(a, b, c) __builtin_amdgcn_mfma_f32_32x32x16_bf16((a), (b), (c), 0, 0, 0)
typedef short v4i16_t __attribute__((ext_vector_type(4)));
template <int CTRL> __device__ __forceinline__ float dppq(float v) { return __builtin_bit_cast(float, __builtin_amdgcn_mov_dpp(__builtin_bit_cast(int, v), CTRL, 0xF, 0xF, true)); }
__device__ __forceinline__ f32x16 zero16() { f32x16 z;
#pragma unroll
    for (int i = 0; i < 16; ++i) z[i] = 0.f; return z; }
__device__ __forceinline__ int img_off(int row, int ch) { return 256 * row + 16 * (ch ^ (((row & 3) << 2) | ((row >> 2) & 3))); }
__device__ __forceinline__ bf16x8 img_row(const LAS unsigned char* img, int r0, int ks, int lane) { return *(const LAS bf16x8*)(img + img_off(r0 + (lane & 31), 2 * ks + (lane >> 5))); }
__device__ __forceinline__ bf16x8 img_tr(const LAS unsigned char* img, int k0, int n0, int lane) {
    const int i = lane & 15, q = i >> 2, p = i & 3, g = lane >> 4, row = k0 + 8 * (g >> 1) + q, ch = (n0 >> 3) + 2 * (g & 1) + (p >> 1);
    const v4i16_t lo = __builtin_amdgcn_ds_read_tr16_b64_v4i16((LAS v4i16_t*)(img + img_off(row, ch) + 8 * (p & 1)));
    const v4i16_t hi = __builtin_amdgcn_ds_read_tr16_b64_v4i16((LAS v4i16_t*)(img + img_off(row + 4, ch) + 8 * (p & 1)));
    return __builtin_shufflevector(lo, hi, 0, 1, 2, 3, 4, 5, 6, 7);
}
__device__ __forceinline__ bf16x8 pad_row(const LAS bf16_t* t, int ld, int r0, int ks, int lane) { return *(const LAS bf16x8*)(t + (r0 + (lane & 31)) * ld + 16 * ks + 8 * (lane >> 5)); }
__device__ __forceinline__ void unpack16(const u32x4 a, const u32x4 b, float (&f)[16]) {
#pragma unroll
    for (int e = 0; e < 4; ++e) { f[2 * e] = bflo(a[e]); f[2 * e + 1] = bfhi(a[e]); f[8 + 2 * e] = bflo(b[e]); f[8 + 2 * e + 1] = bfhi(b[e]); }
}
__device__ __forceinline__ void pack16(const float (&f)[16], float s, u32x4& a, u32x4& b) {
#pragma unroll
    for (int e = 0; e < 4; ++e) { a[e] = cvtpk(f[2 * e] * s, f[2 * e + 1] * s); b[e] = cvtpk(f[8 + 2 * e] * s, f[8 + 2 * e + 1] * s); }
}
__device__ __forceinline__ u32x2 pack4(const f32x16& v, int q4, float s0, float s1, float s2, float s3) { u32x2 w; w.x = cvtpk(v[4 * q4] * s0, v[4 * q4 + 1] * s1); w.y = cvtpk(v[4 * q4 + 2] * s2, v[4 * q4 + 3] * s3); return w; }

template <int J> __device__ __forceinline__ void tsolve_step(float (&x)[16], const LAS float* ap, int p) {
    const float xv = x[J >> 2];
    const float xj = dppq<((J & 3) == 0 ? 0x00 : (J & 3) == 1 ? 0x55 : (J & 3) == 2 ? 0xAA : 0xFF)>(xv);
    constexpr int G0 = (J >> 2) >> 2;
#pragma unroll
    for (int g = G0; g < 4; ++g) { const f32x4 a = *(const LAS f32x4*)(ap + J * 64 + 4 * g);
#pragma unroll
        for (int e = 0; e < 4; ++e) { const int ii = 4 * g + e;
            if (ii > (J >> 2)) x[ii] -= a[e] * xj;
            else if (ii == (J >> 2) && (J & 3) < 3) x[ii] -= (p > (J & 3)) ? a[e] * xj : 0.f; } }
    if constexpr (J + 1 < 63) tsolve_step<J + 1>(x, ap, p);
}
__device__ __forceinline__ void p_dnprep(const Ctx& C) {
    const Args& A = *C.a; const bf16_t* QKVR = (const bf16_t*)(A.ws + WS_QKVR); const float* AB = (const float*)(A.ws + WS_AB);
    bf16_t* QP = (bf16_t*)(A.ws + WS_QP); bf16_t* KP = (bf16_t*)(A.ws + WS_KP); bf16_t* VP = (bf16_t*)(A.ws + WS_VP);
    float* GC = (float*)(A.ws + WS_GCUM); float* BT = (float*)(A.ws + WS_BETA);
    LAS float* cw = (LAS float*)C.lds;
    for (int e = C.tid; e < 3 * 1536; e += NTHREADS) cw[e] = A.in[IN_ECONV][e];
    __syncthreads();
    const int tj = C.tid & 7;
    for (int item = (C.bid * NTHREADS + C.tid) >> 3; item < MT * 4; item += (C.G * NTHREADS) >> 3) {
        const int h = item & 3, row = item >> 2; const int t = row < ML ? (row & (SEQL - 1)) : ((row - ML) & (CTXL - 1)); const bool okm = t > 0, okp = t < (row < ML ? SEQL - 1 : CTXL - 1);
        const bf16_t* p = QKVR + (size_t)row * 1536 + h * 128 + tj * 16;
        float y[3][16];
#pragma unroll
        for (int seg = 0; seg < 3; ++seg) {
            const bf16_t* ps = p + seg * 512; const u32x4 z = {0u, 0u, 0u, 0u};
            const u32x4 c0 = *(const u32x4*)ps, c1 = *(const u32x4*)(ps + 8);
            const u32x4 m0 = okm ? *(const u32x4*)(ps - 1536) : z, m1 = okm ? *(const u32x4*)(ps - 1536 + 8) : z;
            const u32x4 p0 = okp ? *(const u32x4*)(ps + 1536) : z, p1 = okp ? *(const u32x4*)(ps + 1536 + 8) : z;
            float xm[16], xc[16], xp[16]; unpack16(m0, m1, xm); unpack16(c0, c1, xc); unpack16(p0, p1, xp);
            const LAS float* w = cw + seg * 512 + h * 128 + tj * 16;
#pragma unroll
            for (int e = 0; e < 16; ++e) y[seg][e] = silu_f(xm[e] * w[e] + xc[e] * w[1536 + e] + xp[e] * w[3072 + e]);
        }
        float sq = 0.f, sk = 0.f;
#pragma unroll
        for (int e = 0; e < 16; ++e) { sq += y[0][e] * y[0][e]; sk += y[1][e] * y[1][e]; }
        sq += __shfl_xor(sq, 1); sq += __shfl_xor(sq, 2); sq += __shfl_xor(sq, 4);
        sk += __shfl_xor(sk, 1); sk += __shfl_xor(sk, 2); sk += __shfl_xor(sk, 4);
        const float rq = rsqrtf(sq + NORM_EPS) * 0.088388347648318447f, rk = rsqrtf(sk + NORM_EPS);
        const size_t off = (size_t)row * 512 + h * 128 + tj * 16; u32x4 a, b;
        pack16(y[0], rq, a, b); *(u32x4*)(QP + off) = a; *(u32x4*)(QP + off + 8) = b;
        pack16(y[1], rk, a, b); *(u32x4*)(KP + off) = a; *(u32x4*)(KP + off + 8) = b;
        pack16(y[2], 1.f, a, b); *(u32x4*)(VP + off) = a; *(u32x4*)(VP + off + 8) = b;
    }
    const int gw = C.vcu * NWAVES + C.wave, NGW = C.G * NWAVES;
    for (int item = gw; item < 2 * NB * 4 * 36; item += NGW) {
        const int n = item % 36, r2 = item / 36, h = r2 & 3, b = (r2 >> 2) & 15, dir = r2 >> 6;
        const int base = n < 4 ? ML + b * CTXL + (dir ? 3 - n : n) * 64 : b * SEQL + (dir ? 31 - (n - 4) : (n - 4)) * 64;
        const int row = base + (dir ? 63 - C.lane : C.lane);
        const float av = AB[(size_t)row * 16 + dir * 4 + h] + A.in[IN_EDTB][dir * 4 + h], bv = AB[(size_t)row * 16 + 8 + dir * 4 + h];
        const float sp = av > 20.f ? av : log1pf(__expf(av));
        float la = -__expf(A.in[IN_EALOG][dir * 4 + h]) * sp;
#pragma unroll
        for (int d = 1; d < 64; d <<= 1) { const float tt = __shfl_up(la, d); if (C.lane >= d) la += tt; }
        GC[(size_t)(dir * 4 + h) * MT + row] = la; BT[(size_t)(dir * 4 + h) * MT + row] = sigmoid_f(bv);
    }
}

__device__ __forceinline__ void chunk_base(int n, int b, int dir, int& base) {
    if (n < 4) base = ML + b * CTXL + (dir ? 3 - n : n) * 64; else base = b * SEQL + (dir ? 31 - (n - 4) : (n - 4)) * 64;
}

__device__ __forceinline__ void dn_chain(const Ctx& C, int b, int h, int dir) {
    const Args& A = *C.a;
    const bf16_t* QP = (const bf16_t*)(A.ws + WS_QP); const bf16_t* KP = (const bf16_t*)(A.ws + WS_KP); const bf16_t* VP = (const bf16_t*)(A.ws + WS_VP);
    const float* GC = (const float*)(A.ws + WS_GCUM) + (size_t)(dir * 4 + h) * MT; const float* BT = (const float*)(A.ws + WS_BETA) + (size_t)(dir * 4 + h) * MT;
    bf16_t* OUT = (bf16_t*)A.out + (size_t)dir * MT * 512;
    const int tid0 = C.tid, wid = C.wave, lane0 = C.lane;
    for (int e = tid0; e < 8704; e += NTHREADS) ((LAS unsigned*)(C.lds + S_ST))[e] = 0u;
    f32x16 accS[2]; accS[0] = zero16(); accS[1] = zero16();
    const int mt = wid >> 2, nt = wid & 3;
    u32x4 pf[6]; float pg, pb, pgl;
    auto prefetch = [&](int n) {
        int base; chunk_base(n, b, dir, base); const int ti = tid0 >> 3, tj = tid0 & 7;
        const int row = base + (dir ? 63 - ti : ti); const size_t off = (size_t)row * 512 + h * 128 + tj * 16;
        pf[0] = *(const u32x4*)(QP + off); pf[1] = *(const u32x4*)(QP + off + 8); pf[2] = *(const u32x4*)(KP + off); pf[3] = *(const u32x4*)(KP + off + 8); pf[4] = *(const u32x4*)(VP + off); pf[5] = *(const u32x4*)(VP + off + 8);
        pg = GC[row]; pb = BT[row]; pgl = GC[base + (dir ? 0 : 63)];
    };
    prefetch(0);
    __syncthreads();
    for (int n = 0; n < 36; ++n) {
        int zoff = 0; asm volatile("" : "+s"(zoff));
        LAS unsigned char* lds = C.lds + zoff;
        LAS bf16_t* St = (LAS bf16_t*)(lds + S_ST); LAS unsigned char* Ki = lds + S_KI; LAS bf16_t* Qt = (LAS bf16_t*)(lds + S_Q); LAS float* Acol = (LAS float*)(lds + S_ACOL); LAS unsigned char* NWi = lds + S_ACOL;
        LAS bf16_t* QKm = (LAS bf16_t*)(lds + S_QKM); LAS bf16_t* Tm = (LAS bf16_t*)(lds + S_TM); LAS unsigned char* KBGi = lds + S_KBG; LAS unsigned char* VBi = lds + S_VB;
        LAS bf16_t* VNt = (LAS bf16_t*)(lds + S_KBG); LAS bf16_t* VNs = (LAS bf16_t*)(lds + S_VB);
        LAS float* GS = (LAS float*)(lds + S_GS); LAS float* BS = (LAS float*)(lds + S_BS); LAS float* EG = (LAS float*)(lds + S_EG); LAS float* EK = (LAS float*)(lds + S_EK);
        const int tid = tid0 + zoff, lane = lane0 + zoff, r = lane & 31, hh = lane >> 5, ti = tid >> 3, tj = tid & 7;
        int base; chunk_base(n, b, dir, base);
        {
            float q[16], k[16], v[16]; unpack16(pf[0], pf[1], q); unpack16(pf[2], pf[3], k); unpack16(pf[4], pf[5], v);
            const float g_i = pg, beta_i = pb, eg = __expf(g_i), ek = __expf(pgl - g_i);
            *(LAS u32x4*)(Ki + img_off(ti, 2 * tj)) = pf[2]; *(LAS u32x4*)(Ki + img_off(ti, 2 * tj + 1)) = pf[3];
            *(LAS u32x4*)(Qt + ti * LDK + tj * 16) = pf[0]; *(LAS u32x4*)(Qt + ti * LDK + tj * 16 + 8) = pf[1];
            u32x4 a, bb; pack16(k, beta_i * eg, a, bb); *(LAS u32x4*)(KBGi + img_off(ti, 2 * tj)) = a; *(LAS u32x4*)(KBGi + img_off(ti, 2 * tj + 1)) = bb;
            pack16(v, beta_i, a, bb); *(LAS u32x4*)(VBi + img_off(ti, 2 * tj)) = a; *(LAS u32x4*)(VBi + img_off(ti, 2 * tj + 1)) = bb;
            if (tj == 0) { GS[ti] = g_i; BS[ti] = beta_i; EG[ti] = eg; EK[ti] = ek; }
        }
        const float cd = __expf(pgl);
        if (n + 1 < 36) prefetch(n + 1);
        __syncthreads();
        {
            const int w4 = wid & 3, cm = w4 >> 1, cn = w4 & 1;
            if (!(cm == 0 && cn == 1)) {
                f32x16 acc = zero16();
#pragma unroll
                for (int ks = 0; ks < 8; ++ks) { const bf16x8 a = wid < 4 ? img_row(Ki, 32 * cm, ks, lane) : pad_row(Qt, LDK, 32 * cm, ks, lane); acc = MFMA32(a, img_row(Ki, 32 * cn, ks, lane), acc); }
                const int jj = 32 * cn + r; const float gj = GS[jj];
#pragma unroll
                for (int reg = 0; reg < 16; ++reg) { const int ii = 32 * cm + crow(reg, hh); const float dec = __expf(fminf(GS[ii] - gj, 0.f));
                    if (wid < 4) { Acol[jj * 64 + (ii & 3) * 16 + (ii >> 2)] = ii > jj ? BS[ii] * acc[reg] * dec : 0.f; }
                    else QKm[ii * LDC + jj] = f2bf(ii >= jj ? acc[reg] * dec : 0.f); }
            } else if (wid >= 4) {
#pragma unroll
                for (int reg = 0; reg < 16; ++reg) QKm[crow(reg, hh) * LDC + 32 + r] = 0;
            }
        }
        __syncthreads();
        if (wid < 4) {
            const int col = tid >> 2, p = tid & 3; const LAS float* ap = Acol + p * 16;
            float x[16];
#pragma unroll
            for (int ii = 0; ii < 16; ++ii) x[ii] = (4 * ii + p == col) ? 1.f : 0.f;
            tsolve_step<0>(x, ap, p);
#pragma unroll
            for (int ii = 0; ii < 16; ++ii) Tm[(4 * ii + p) * LDC + col] = f2bf(x[ii]);
        }
        __syncthreads();
        f32x16 uacc = zero16();
        {
#pragma unroll
            for (int ks = 0; ks < 4; ++ks) uacc = MFMA32(pad_row(Tm, LDC, 32 * mt, ks, lane), img_tr(VBi, 16 * ks, 32 * nt, lane), uacc);
            const int kt = wid & 3, ct = wid >> 2; f32x16 wacc = zero16();
#pragma unroll
            for (int ks = 0; ks < 4; ++ks) wacc = MFMA32(img_tr(KBGi, 16 * ks, 32 * kt, lane), pad_row(Tm, LDC, 32 * ct, ks, lane), wacc);
#pragma unroll
            for (int q4 = 0; q4 < 4; ++q4) *(LAS u32x2*)(NWi + img_off(32 * ct + r, 4 * kt + q4) + 8 * hh) = pack4(wacc, q4, -1.f, -1.f, -1.f, -1.f);
        }
        __syncthreads();
        {
#pragma unroll
            for (int ks = 0; ks < 8; ++ks) uacc = MFMA32(img_row(NWi, 32 * mt, ks, lane), pad_row(St, LDK, 32 * nt, ks, lane), uacc);
#pragma unroll
            for (int q4 = 0; q4 < 4; ++q4) { const int c0 = 32 * mt + 8 * q4 + 4 * hh; const f32x4 ekv = *(const LAS f32x4*)(EK + c0);
                *(LAS u32x2*)(VNt + (32 * nt + r) * LDC + c0) = pack4(uacc, q4, 1.f, 1.f, 1.f, 1.f);
                *(LAS u32x2*)(VNs + (32 * nt + r) * LDC + c0) = pack4(uacc, q4, ekv[0], ekv[1], ekv[2], ekv[3]); }
        }
        __syncthreads();
        {
            f32x16 oacc = zero16();
#pragma unroll
            for (int ks = 0; ks < 8; ++ks) oacc = MFMA32(pad_row(Qt, LDK, 32 * mt, ks, lane), pad_row(St, LDK, 32 * nt, ks, lane), oacc);
#pragma unroll
            for (int q4 = 0; q4 < 4; ++q4) { const f32x4 egv = *(const LAS f32x4*)(EG + 32 * mt + 8 * q4 + 4 * hh);
#pragma unroll
                for (int i = 0; i < 4; ++i) oacc[4 * q4 + i] *= egv[i]; }
#pragma unroll
            for (int ks = 0; ks < 4; ++ks) oacc = MFMA32(pad_row(QKm, LDC, 32 * mt, ks, lane), pad_row(VNt, LDC, 32 * nt, ks, lane), oacc);
#pragma unroll
            for (int reg = 0; reg < 16; ++reg) { const int ii = 32 * mt + crow(reg, hh); const int row = base + (dir ? 63 - ii : ii);
                OUT[(size_t)row * 512 + h * 128 + 32 * nt + r] = f2bf(oacc[reg]); }
#pragma unroll
            for (int t = 0; t < 2; ++t) { const int kt = mt * 2 + t; accS[t] = accS[t] * cd;
#pragma unroll
                for (int ks = 0; ks < 4; ++ks) accS[t] = MFMA32(img_tr(Ki, 16 * ks, 32 * kt, lane), pad_row(VNs, LDC, 32 * nt, ks, lane), accS[t]); }
        }
        __syncthreads();
#pragma unroll
        for (int t = 0; t < 2; ++t) { const int kt = mt * 2 + t;
#pragma unroll
            for (int q4 = 0; q4 < 4; ++q4) *(LAS u32x2*)(St + (32 * nt + r) * LDK + 32 * kt + 8 * q4 + 4 * hh) = pack4(accS[t], q4, 1.f, 1.f, 1.f, 1.f); }
    }
    __syncthreads();
}

__device__ __forceinline__ void ret_chain(const Ctx& C, int b, int h, int dir) {
    const Args& A = *C.a;
    const bf16_t* RQ = (const bf16_t*)(A.ws + WS_RQ); const bf16_t* RK = (const bf16_t*)(A.ws + WS_RK); const bf16_t* RV = (const bf16_t*)(A.ws + WS_RV);
    bf16_t* OUT = dir == 0 ? (bf16_t*)A.out + (size_t)2 * MT * 512 : (bf16_t*)(A.ws + WS_O3);
    const int tid0 = C.tid, wid = C.wave, lane0 = C.lane;
    for (int e = tid0; e < 8704; e += NTHREADS) ((LAS unsigned*)(C.lds + S_ST))[e] = 0u;
    f32x16 accS[2]; accS[0] = zero16(); accS[1] = zero16();
    const float lg = -__expf(A.in[IN_ERETD][dir * 4 + h]);
    const float cdec = __expf(lg * 64.f), eki = __expf(lg * (float)(63 - (tid0 >> 3)));
    const int mt = wid >> 2, nt = wid & 3;
    u32x4 pf[6];
    auto prefetch = [&](int n) {
        int base; chunk_base(n, b, dir, base); const int ti = tid0 >> 3, tj = tid0 & 7;
        const int row = base + (dir ? 63 - ti : ti); const size_t off = (size_t)row * 512 + h * 128 + tj * 16;
        pf[0] = *(const u32x4*)(RQ + off); pf[1] = *(const u32x4*)(RQ + off + 8); pf[2] = *(const u32x4*)(RK + off); pf[3] = *(const u32x4*)(RK + off + 8); pf[4] = *(const u32x4*)(RV + off); pf[5] = *(const u32x4*)(RV + off + 8);
    };
    prefetch(0);
    __syncthreads();
    for (int n = 0; n < 36; ++n) {
        int zoff = 0; asm volatile("" : "+s"(zoff));
        LAS unsigned char* lds = C.lds + zoff;
        LAS bf16_t* St = (LAS bf16_t*)(lds + S_ST); LAS unsigned char* Ki = lds + R_KI; LAS bf16_t* Qt = (LAS bf16_t*)(lds + R_Q); LAS unsigned char* Vi = lds + R_VI; LAS unsigned char* Vs = lds + R_VS; LAS bf16_t* Pm = (LAS bf16_t*)(lds + R_PM);
        const int tid = tid0 + zoff, lane = lane0 + zoff, r = lane & 31, hh = lane >> 5, ti = tid >> 3, tj = tid & 7;
        int base; chunk_base(n, b, dir, base);
        {
            float v[16]; unpack16(pf[4], pf[5], v);
            *(LAS u32x4*)(Ki + img_off(ti, 2 * tj)) = pf[2]; *(LAS u32x4*)(Ki + img_off(ti, 2 * tj + 1)) = pf[3];
            *(LAS u32x4*)(Qt + ti * LDK + tj * 16) = pf[0]; *(LAS u32x4*)(Qt + ti * LDK + tj * 16 + 8) = pf[1];
            *(LAS u32x4*)(Vi + img_off(ti, 2 * tj)) = pf[4]; *(LAS u32x4*)(Vi + img_off(ti, 2 * tj + 1)) = pf[5];
            u32x4 a, bb; pack16(v, eki, a, bb); *(LAS u32x4*)(Vs + img_off(ti, 2 * tj)) = a; *(LAS u32x4*)(Vs + img_off(ti, 2 * tj + 1)) = bb;
        }
        if (n + 1 < 36) prefetch(n + 1);
        __syncthreads();
        if (wid < 4) {
            const int cm = wid >> 1, cn = wid & 1;
            if (!(cm == 0 && cn == 1)) {
                f32x16 acc = zero16();
#pragma unroll
                for (int ks = 0; ks < 8; ++ks) acc = MFMA32(pad_row(Qt, LDK, 32 * cm, ks, lane), img_row(Ki, 32 * cn, ks, lane), acc);
                const int jj = 32 * cn + r;
#pragma unroll
                for (int reg = 0; reg < 16; ++reg) { const int ii = 32 * cm + crow(reg, hh); Pm[ii * LDC + jj] = f2bf(ii >= jj ? acc[reg] * __expf(lg * (float)(ii - jj)) : 0.f); }
            } else {
#pragma unroll
                for (int reg = 0; reg < 16; ++reg) Pm[crow(reg, hh) * LDC + 32 + r] = 0;
            }
        }
        __syncthreads();
        {
            f32x16 oacc = zero16();
#pragma unroll
            for (int ks = 0; ks < 8; ++ks) oacc = MFMA32(pad_row(Qt, LDK, 32 * mt, ks, lane), pad_row(St, LDK, 32 * nt, ks, lane), oacc);
#pragma unroll
            for (int reg = 0; reg < 16; ++reg) oacc[reg] *= __expf(lg * (float)(32 * mt + crow(reg, hh) + 1));
#pragma unroll
            for (int ks = 0; ks < 4; ++ks) oacc = MFMA32(pad_row(Pm, LDC, 32 * mt, ks, lane), img_tr(Vi, 16 * ks, 32 * nt, lane), oacc);
#pragma unroll
            for (int reg = 0; reg < 16; ++reg) { const int ii = 32 * mt + crow(reg, hh); const int row = base + (dir ? 63 - ii : ii);
                OUT[(size_t)row * 512 + h * 128 + 32 * nt + r] = f2bf(oacc[reg]); }
#pragma unroll
            for (int t = 0; t < 2; ++t) { const int kt = mt * 2 + t; accS[t] = accS[t] * cdec;
#pragma unroll
                for (int ks = 0; ks < 4; ++ks) accS[t] = MFMA32(img_tr(Ki, 16 * ks, 32 * kt, lane), img_tr(Vs, 16 * ks, 32 * nt, lane), accS[t]); }
        }
        __syncthreads();
#pragma unroll
        for (int t = 0; t < 2; ++t) { const int kt = mt * 2 + t;
#pragma unroll
            for (int q4 = 0; q4 < 4; ++q4) *(LAS u32x2*)(St + (32 * nt + r) * LDK + 32 * kt + 8 * q4 + 4 * hh) = pack4(accS[t], q4, 1.f, 1.f, 1.f, 1.f); }
    }
    __syncthreads();
}
__device__ __forceinline__ void p_scan(const Ctx& C) {
    for (int ch = C.bid; ch < 256; ch += C.G) {
        const int kind = ch >> 7, rest = ch & 127, b = rest >> 3, h = (rest >> 1) & 3, dir = rest & 1;
        if (kind == 0) dn_chain(C, b, h, dir); else ret_chain(C, b, h, dir);
    }
}
}
namespace attn {
constexpr int LDT = 72;
constexpr int KS_BYTES = 64 * LDT * 2, VS_BYTES = 128 * LDT * 2, STAGE = 2 * KS_BYTES + VS_BYTES;
constexpr int EX_OFF = 0, YST_OFF = 81920;
static_assert(2 * STAGE <= YST_OFF && YST_OFF + 4 * 32 * 136 * 2 <= LDS_BYTES, "attn LDS map");
#define MFMA32(a, b, c) __builtin_amdgcn_mfma_f32_32x32x16_bf16((a), (b), (c), 0, 0, 0)
__device__ __forceinline__ void p_attn(const Ctx& C) {
    const Args& A = *C.a; LAS unsigned char* lds = C.lds;
    const bf16_t* Q1 = (const bf16_t*)(A.ws + WS_Q1); const bf16_t* K1 = (const bf16_t*)(A.ws + WS_K1); const bf16_t* VT = (const bf16_t*)(A.ws + WS_VT); bf16_t* Y1 = (bf16_t*)(A.ws + WS_Y1);
    const float lam = ((const float*)(A.ws + WS_CTL))[0];
    const int tid = C.tid, wid = C.wave, lane = C.lane, r = lane & 31, hh = lane >> 5, comp = wid & 1, qs = wid >> 1;
    for (int unit = C.vcu; unit < NB * 8 * 16; unit += C.G) {
        const int bh = unit >> 4, qb = unit & 15, b = bh >> 3, hd = bh & 7;
        const int qrow0 = b * SEQL + qb * 128 + qs * 32;
        bf16x8 qr[4];
#pragma unroll
        for (int ks = 0; ks < 4; ++ks) qr[ks] = *(const bf16x8*)(Q1 + (size_t)(qrow0 + r) * 1024 + hd * 128 + comp * 64 + 16 * ks + 8 * hh);
        u32x4 st[4];
        auto gload = [&](int kt) {
            const int krow0 = kt < 32 ? b * SEQL + 64 * kt : ML + b * CTXL + 64 * (kt - 32);
#pragma unroll
            for (int i = 0; i < 2; ++i) { const int c = tid + 512 * i; const int key = c >> 4, ch = c & 15; st[i] = *(const u32x4*)(K1 + (size_t)(krow0 + key) * 1024 + hd * 128 + ch * 8); }
#pragma unroll
            for (int i = 0; i < 2; ++i) { const int c = tid + 512 * i; const int dv = c >> 3, ch = c & 7; st[2 + i] = *(const u32x4*)(VT + (size_t)(hd * 128 + dv) * MT + krow0 + ch * 8); }
        };
        auto lstore = [&](int buf) {
            LAS unsigned char* sb = lds + buf * STAGE;
#pragma unroll
            for (int i = 0; i < 2; ++i) { const int c = tid + 512 * i; const int key = c >> 4, ch = c & 15; *(LAS u32x4*)(sb + (ch >> 3) * KS_BYTES + (key * LDT + (ch & 7) * 8) * 2) = st[i]; }
#pragma unroll
            for (int i = 0; i < 2; ++i) { const int c = tid + 512 * i; const int dv = c >> 3, ch = c & 7; *(LAS u32x4*)(sb + 2 * KS_BYTES + (dv * LDT + ch * 8) * 2) = st[2 + i]; }
        };
        gload(0); lstore(0); gload(1);
        float m_run = -1e30f, l_run = 0.f;
        f32x16 o[4];
#pragma unroll
        for (int dt = 0; dt < 4; ++dt)
#pragma unroll
            for (int i = 0; i < 16; ++i) o[dt][i] = 0.f;
        __syncthreads();
        for (int kt = 0; kt < 36; ++kt) {
            const LAS unsigned char* sb = lds + (kt & 1) * STAGE;
            const LAS bf16_t* Ks = (const LAS bf16_t*)(sb + comp * KS_BYTES); const LAS bf16_t* Vs = (const LAS bf16_t*)(sb + 2 * KS_BYTES);
            f32x16 p[2];
#pragma unroll
            for (int kk = 0; kk < 2; ++kk) {
#pragma unroll
                for (int i = 0; i < 16; ++i) p[kk][i] = 0.f;
#pragma unroll
                for (int ks = 0; ks < 4; ++ks) { const bf16x8 a = *(const LAS bf16x8*)(Ks + (32 * kk + r) * LDT + 16 * ks + 8 * hh); p[kk] = MFMA32(a, qr[ks], p[kk]); }
            }
            float mx = p[0][0];
#pragma unroll
            for (int i = 0; i < 16; ++i) { mx = fmaxf(mx, p[0][i]); mx = fmaxf(mx, p[1][i]); }
            mx = fmaxf(mx, __shfl_xor(mx, 32));
            const float m_new = fmaxf(m_run, mx); const float alpha = exp2f(m_run - m_new); m_run = m_new;
            float ls = 0.f;
#pragma unroll
            for (int kk = 0; kk < 2; ++kk)
#pragma unroll
                for (int i = 0; i < 16; ++i) { const float e = exp2f(p[kk][i] - m_new); p[kk][i] = e; ls += e; }
            l_run = l_run * alpha + ls;
#pragma unroll
            for (int dt = 0; dt < 4; ++dt) o[dt] = o[dt] * alpha;
#pragma unroll
            for (int kk = 0; kk < 2; ++kk)
#pragma unroll
                for (int s = 0; s < 2; ++s) {
                    u32x4 pw; pw.x = cvtpk(p[kk][8 * s], p[kk][8 * s + 1]); pw.y = cvtpk(p[kk][8 * s + 2], p[kk][8 * s + 3]); pw.z = cvtpk(p[kk][8 * s + 4], p[kk][8 * s + 5]); pw.w = cvtpk(p[kk][8 * s + 6], p[kk][8 * s + 7]);
                    const bf16x8 pf = __builtin_bit_cast(bf16x8, pw);
#pragma unroll
                    for (int dt = 0; dt < 4; ++dt) {
                        const LAS bf16_t* vp = Vs + (32 * dt + r) * LDT + 32 * kk + 16 * s + 4 * hh;
                        const s16x4 lo = *(const LAS s16x4*)vp, hi = *(const LAS s16x4*)(vp + 8);
                        const bf16x8 vf = __builtin_shufflevector(lo, hi, 0, 1, 2, 3, 4, 5, 6, 7);
                        o[dt] = MFMA32(vf, pf, o[dt]);
                    }
                }
            if (kt + 1 < 36) lstore((kt + 1) & 1);
            if (kt + 2 < 36) gload(kt + 2);
            __syncthreads();
        }
        l_run += __shfl_xor(l_run, 32);
        const float inv = 1.f / l_run;
        LAS float* EX = (LAS float*)(lds + EX_OFF) + qs * 128 * 32;
        if (comp == 1) {
#pragma unroll
            for (int dt = 0; dt < 4; ++dt)
#pragma unroll
                for (int i = 0; i < 16; ++i) EX[(32 * dt + crow(i, hh)) * 32 + r] = o[dt][i] * inv * lam;
        }
        __syncthreads();
        if (comp == 0) {
            float ss = 0.f;
#pragma unroll
            for (int dt = 0; dt < 4; ++dt)
#pragma unroll
                for (int i = 0; i < 16; ++i) { const float v = o[dt][i] * inv - EX[(32 * dt + crow(i, hh)) * 32 + r]; o[dt][i] = v; ss += v * v; }
            ss += __shfl_xor(ss, 32);
            const float rn = rsqrtf(ss * (1.f / 128.f) + NORM_EPS) * (1.f - LAMBDA_INIT1);
            LAS bf16_t* ys = (LAS bf16_t*)(lds + YST_OFF) + qs * 32 * 136;
#pragma unroll
            for (int dt = 0; dt < 4; ++dt)
#pragma unroll
                for (int q4 = 0; q4 < 4; ++q4) { const int dv = 32 * dt + 8 * q4 + 4 * hh; const f32x4 sw = *(const f32x4*)(A.in[IN_OSUBLN] + dv);
                    u32x2 w; w.x = cvtpk(o[dt][4 * q4] * rn * sw[0], o[dt][4 * q4 + 1] * rn * sw[1]); w.y = cvtpk(o[dt][4 * q4 + 2] * rn * sw[2], o[dt][4 * q4 + 3] * rn * sw[3]);
                    *(LAS u32x2*)(ys + r * 136 + dv) = w; }
            asm volatile("s_waitcnt lgkmcnt(0)" ::: "memory");
#pragma unroll
            for (int i = 0; i < 8; ++i) { const int row = i * 4 + (lane >> 4), ch = lane & 15; const u32x4 v = *(const LAS u32x4*)(ys + row * 136 + ch * 8);
                *(u32x4*)(Y1 + (size_t)(qrow0 + row) * 1024 + hd * 128 + ch * 8) = v; }
        }
        __syncthreads();
    }
}
}
__global__ void __launch_bounds__(NTHREADS, 2) fwd_kernel(Args args, int ph_lo, int ph_hi) {
    extern __shared__ __attribute__((aligned(16))) unsigned char lds_raw[];
    cg::grid_group grid = cg::this_grid();
    Ctx C; C.lds = (LAS unsigned char*)lds_raw; C.tid = threadIdx.x; C.lane = C.tid & 63; C.wave = __builtin_amdgcn_readfirstlane(C.tid >> 6);
    C.G = gridDim.x; C.bid = blockIdx.x; C.vcu = (C.G % 8 == 0) ? (C.bid % 8) * (C.G / 8) + C.bid / 8 : C.bid; C.a = &args;
    unsigned char* ws = args.ws;
    const float* MOD0 = (const float*)(ws + WS_MOD); const float* MOD1 = MOD0 + 17 * 6144;
    const float* lng = args.in[IN_LNG]; const float* lnb = args.in[IN_LNB];
    bf16_t* H = (bf16_t*)(ws + WS_H);
    float* XRC = (float*)(ws + WS_XRC);
#ifndef PHMASK
#define PHMASK 0xFFFFFFFFu
#endif
#define IN(k) (((PHMASK >> (k)) & 1u) && ph_lo <= (k) && (k) < ph_hi)
#define SEAM(k) do { if (IN(k) && IN((k) + 1)) grid.sync(); } while (0)
    if (IN(0)) { p0_weights_l0(C); __syncthreads(); p0_mod(C); p0_tables(C); }
    SEAM(0);
    if (IN(1)) p1_modulate_ab(C);
    SEAM(1);
    if (IN(2)) {
        pg8::Order S; S.init(1024, C.G, C.bid, pg8::GemmDesc{H, (const bf16_t*)(ws + WS_WIN), MT / 256, 16});
        epi::EpiIn E{(bf16_t*)(ws + WS_QKVR), (bf16_t*)(ws + WS_Z), (bf16_t*)(ws + WS_RQ), (bf16_t*)(ws + WS_RK), (bf16_t*)(ws + WS_RV), (bf16_t*)(ws + WS_RG), (const float*)(ws + WS_RETCS)};
        pg8::gemm_phase<epi::EpiIn>(C.lds, S, E);
#ifdef PROBE_GEMM4
        pg8::gemm_phase<epi::EpiIn>(C.lds, S, E);
#endif
    }
    SEAM(2);
    if (IN(3)) { scan::p_dnprep(C);
#ifdef PROBE_PREP
        __syncthreads(); scan::p_dnprep(C);
#endif
        grid.sync(); scan::p_scan(C);
#ifdef PROBE_SCAN
        __syncthreads(); scan::p_scan(C);
#endif
    }
    SEAM(3);
    if (IN(4)) p5_finish(C);
    SEAM(4);
    if (IN(5)) {
        pg8::Order S; S.init(1024, C.G, C.bid, pg8::GemmDesc{H, (const bf16_t*)(ws + WS_WOUT0), MT / 256, 4});
        epi::EpiRes E{args.in[IN_X], args.in[IN_CTX], args.out, XRC, MOD0 + 2048};
        pg8::gemm_phase<epi::EpiRes>(C.lds, S, E);
    }
    SEAM(5);
    if (IN(6)) p_ln(C, MT, lng, lnb, MOD0, 3072, 4096, true);
    SEAM(6);
    if (IN(7)) {
        pg8::Order S; S.init(1024, C.G, C.bid, pg8::GemmDesc{H, (const bf16_t*)(ws + WS_WGU), MT / 256, 22});
        epi::EpiGU E{(bf16_t*)(ws + WS_G), (bf16_t*)(ws + WS_U)};
        pg8::gemm_phase<epi::EpiGU>(C.lds, S, E);
#ifdef PROBE_GEMM4
        pg8::gemm_phase<epi::EpiGU>(C.lds, S, E);
#endif
    }
    SEAM(7);
    if (IN(8)) conv::p_conv2(C, 0, true);
    SEAM(8);
    if (IN(9)) {
        pg8::Order S; S.init(DFF, C.G, C.bid, pg8::GemmDesc{(const bf16_t*)(ws + WS_U), (const bf16_t*)(ws + WS_WD), MT / 256, 4});
        epi::EpiRes E{args.out, XRC, args.out, XRC, MOD0 + 5120};
        pg8::gemm_phase<epi::EpiRes>(C.lds, S, E);
    }
    SEAM(9);
    if (IN(10)) { p_ln(C, MT, lng + 1024, lnb + 1024, MOD1, 0, 1024, true); p_weights_l1(C); }
    SEAM(10);
    if (IN(11)) {
        pg8::Order S; S.init2(1024, C.G, C.bid, pg8::GemmDesc{H, (const bf16_t*)(ws + WS_WQK1), MT / 256, 8}, pg8::GemmDesc{(const bf16_t*)(ws + WS_WV1), H, 4, MT / 256});
        epi::EpiQKV1 E{(bf16_t*)(ws + WS_Q1), (bf16_t*)(ws + WS_K1), (bf16_t*)(ws + WS_VT), (const float*)(ws + WS_DIFFCS)};
        pg8::gemm_phase<epi::EpiQKV1>(C.lds, S, E);
#ifdef PROBE_GEMM4
        pg8::gemm_phase<epi::EpiQKV1>(C.lds, S, E);
#endif
    }
    SEAM(11);
    if (IN(12)) { attn::p_attn(C);
#ifdef PROBE_ATTN
        __syncthreads(); attn::p_attn(C);
#endif
    }
    SEAM(12);
    if (IN(13)) {
        pg8::Order S; S.init(1024, C.G, C.bid, pg8::GemmDesc{(const bf16_t*)(ws + WS_Y1), (const bf16_t*)(ws + WS_WO1), ML / 256, 4});
        epi::EpiRes E{args.out, XRC, args.out, XRC, MOD1 + 2048};
        pg8::gemm_phase<epi::EpiRes>(C.lds, S, E);
    }
    SEAM(13);
    if (IN(14)) p_ln(C, ML, lng + 2048, lnb + 2048, MOD1, 3072, 4096, true);
    SEAM(14);
    if (IN(15)) {
        pg8::Order S; S.init(1024, C.G, C.bid, pg8::GemmDesc{H, (const bf16_t*)(ws + WS_WGU), ML / 256, 22});
        epi::EpiGU E{(bf16_t*)(ws + WS_G), (bf16_t*)(ws + WS_U)};
        pg8::gemm_phase<epi::EpiGU>(C.lds, S, E);
#ifdef PROBE_GEMM4
        pg8::gemm_phase<epi::EpiGU>(C.lds, S, E);
#endif
    }
    SEAM(15);
    if (IN(16)) conv::p_conv2(C, 1, false);
    SEAM(16);
    if (IN(17)) {
        pg8::Order S; S.init(DFF, C.G, C.bid, pg8::GemmDesc{(const bf16_t*)(ws + WS_U), (const bf16_t*)(ws + WS_WD), ML / 256, 4});
        epi::EpiRes E{args.out, XRC, args.out, XRC, MOD1 + 5120};
        pg8::gemm_phase<epi::EpiRes>(C.lds, S, E);
    }
    SEAM(17);
    if (IN(18)) p_ln(C, ML, lng + 3072, lnb + 3072, nullptr, 0, 0, false);
#undef IN
#undef SEAM
}
constexpr int N_PHASES = 19;

extern "C" void kernel_launch(void* const* d_in, const int* in_sizes, int n_in, void* d_out, int out_size, void* d_ws, size_t ws_size, hipStream_t stream) {
    static int grid = 0;
    if (grid == 0) {
        if (n_in != 23 || out_size != ML * D || ws_size < WS_END) { fprintf(stderr, "kernel_launch: unexpected problem shape (n_in %d, out %d, ws %zu)\n", n_in, out_size, ws_size); grid = -1; return; }
        int dev = 0, cus = 0, per_cu = 0;
        hipGetDevice(&dev); hipDeviceGetAttribute(&cus, hipDeviceAttributeMultiprocessorCount, dev);
        hipFuncSetAttribute((const void*)fwd_kernel, hipFuncAttributeMaxDynamicSharedMemorySize, LDS_BYTES);
        hipOccupancyMaxActiveBlocksPerMultiprocessor(&per_cu, (const void*)fwd_kernel, NTHREADS, LDS_BYTES);
        (void)hipGetLastError();
        if (per_cu < 1) { fprintf(stderr, "kernel_launch: occupancy query says %d blocks/CU\n", per_cu); per_cu = 1; }
        grid = cus;
        if (grid > cus * per_cu) grid = cus * per_cu;
    }
    if (grid < 0) return;
    Args a{};
    for (int i = 0; i < 23; ++i) a.in[i] = (const float*)d_in[i];
    a.out = (float*)d_out; a.ws = (unsigned char*)d_ws;
#ifndef MK_SPLIT
    int lo = 0, hi = N_PHASES;
    void* kargs[] = {&a, &lo, &hi};
    hipError_t e = hipLaunchCooperativeKernel((const void*)fwd_kernel, dim3(grid), dim3(NTHREADS), kargs, LDS_BYTES, stream);
    if (e != hipSuccess) fprintf(stderr, "cooperative launch failed: %s (grid %d)\n", hipGetErrorString(e), grid);
#else
    for (int p = 0; p < N_PHASES; ++p) {
        int lo = p, hi = p + 1; void* kargs[] = {&a, &lo, &hi};
        hipError_t e = hipLaunchCooperativeKernel((const void*)fwd_kernel, dim3(grid), dim3(NTHREADS), kargs, LDS_BYTES, stream);
        if (e != hipSuccess) { fprintf(stderr, "cooperative launch %d failed: %s (grid %d)\n", p, hipGetErrorString(e), grid); break; }
    }
#endif
}
```
